# Optimizing an MI355X kernel written in HIP

```python
import jax, jax.numpy as jnp
from jax import lax
import numpy as np

D_MODEL = 1024
BATCH = 16
SEQ = 256
DEPTH = 1
DEC_BATCH = 2
DEC_SEQ = 1024
PAST_LEN = 256

GRID_W = 64
HEAD_DIM = 64
H_A = 8
H_B = 8
KV_B = 2
G_B = H_B // KV_B
W_A = H_A * HEAD_DIM
W_B = H_B * HEAD_DIM
KV_W_B = KV_B * HEAD_DIM
MIX_WIDTH = W_A + W_B
IN_WIDTH = 3 * W_A + W_B + 2 * KV_W_B
NA_ROWS = 8
NA_COLS = 16
SWA_WINDOW = 128
BLOCK = 128
D_FF = 2816
ROPE_THETA = 10000.0
EPS = 1e-6
NEG_INF = -1e30

kernel_name = 'hybrid_natten_swa_diffusion_step'


def rmsnorm(x, g):
    xf = x.astype(jnp.float32)
    var = jnp.mean(xf * xf, axis=-1, keepdims=True)
    return (xf * lax.rsqrt(var + EPS)).astype(x.dtype) * g


def adaln(cond, w_mod, b_mod):
    m = (jax.nn.silu(cond) @ w_mod + b_mod)[:, None, :]
    return jnp.split(m, 6, axis=-1)


def modulate(h, shift, scale):
    return h * (1 + scale) + shift


def project(h, w_in):
    B, T, _ = h.shape
    z = h @ w_in
    qa, ka, va, qb, kb, vb = jnp.split(z, [W_A, 2 * W_A, 3 * W_A, 3 * W_A + W_B, 3 * W_A + W_B + KV_W_B], axis=-1)
    r = lambda t, n: t.reshape(B, T, n, HEAD_DIM)
    return r(qa, H_A), r(ka, H_A), r(va, H_A), r(qb, H_B), r(kb, KV_B), r(vb, KV_B)


def rope_axis(x, pos):
    n = x.shape[-1] // 2
    inv = 1.0 / (ROPE_THETA ** (jnp.arange(n, dtype=jnp.float32) / n))
    ang = pos.astype(jnp.float32)[:, None] * inv[None, :]
    cos = jnp.cos(ang)[:, None, :].astype(x.dtype)
    sin = jnp.sin(ang)[:, None, :].astype(x.dtype)
    x1, x2 = x[..., :n], x[..., n:]
    return jnp.concatenate([x1 * cos - x2 * sin, x2 * cos + x1 * sin], axis=-1)


def rope_2d(x):
    t = jnp.arange(x.shape[1])
    half = x.shape[-1] // 2
    return jnp.concatenate([rope_axis(x[..., :half], t // GRID_W), rope_axis(x[..., half:], t % GRID_W)], axis=-1)


def ctx_self_attn(q, k, v, sink):
    B, L, KV, G, D = q.shape
    nb = L // BLOCK
    qb = jnp.moveaxis(q.reshape(B, nb, BLOCK, KV, G, D), 1, 0)
    scale = D ** -0.5

    def one(qblk):
        s = jnp.einsum('bqkgd,blkd->bkgql', qblk, k).astype(jnp.float32) * scale
        if sink is not None:
            sk = jnp.broadcast_to(sink.astype(jnp.float32)[None, :, :, None, None], s.shape[:-1] + (1,))
            p = jax.nn.softmax(jnp.concatenate([sk, s], axis=-1), axis=-1)[..., 1:]
        else:
            p = jax.nn.softmax(s, axis=-1)
        return jnp.einsum('bkgql,blkd->bqkgd', p.astype(v.dtype), v)

    o = lax.map(one, qb)
    return jnp.moveaxis(o, 0, 1).reshape(B, L, KV * G * D)


def neighborhood_attn(q, k, v, ck, cv, rpb):
    B, T, H, D = q.shape
    rows = T // GRID_W
    kr = min(NA_ROWS, rows)
    kc = NA_COLS
    r = jnp.arange(rows)
    c = jnp.arange(GRID_W)
    row_start = jnp.clip(r - kr // 2, 0, rows - kr)
    row_idx = row_start[:, None] + jnp.arange(kr)[None, :]
    col_start = jnp.clip(c - kc // 2, 0, GRID_W - kc)
    col_valid = (c[None, :] >= col_start[:, None]) & (c[None, :] < col_start[:, None] + kc)
    kg = k.reshape(B, rows, GRID_W, H, D)[:, row_idx].reshape(B, rows, kr * GRID_W, H, D)
    vg = v.reshape(B, rows, GRID_W, H, D)[:, row_idx].reshape(B, rows, kr * GRID_W, H, D)
    qg = q.reshape(B, rows, GRID_W, H, D)
    drow = row_idx - r[:, None] + (NA_ROWS - 1)
    dcol = jnp.clip(c[None, :] - c[:, None], -(kc - 1), kc - 1) + (kc - 1)
    bias = rpb[:, drow[:, None, :, None], dcol[None, :, None, :]]
    bias = bias.reshape(H, rows, GRID_W, kr * GRID_W).astype(jnp.float32)
    valid = jnp.broadcast_to(col_valid[:, None, :], (GRID_W, kr, GRID_W)).reshape(GRID_W, kr * GRID_W)
    scale = D ** -0.5
    s_nb = jnp.einsum('brqhd,brkhd->bhrqk', qg, kg).astype(jnp.float32) * scale + bias[None]
    s_nb = jnp.where(valid[None, None, None], s_nb, NEG_INF)
    s_cx = jnp.einsum('brqhd,blhd->bhrql', qg, ck).astype(jnp.float32) * scale
    p = jax.nn.softmax(jnp.concatenate([s_nb, s_cx], axis=-1), axis=-1).astype(v.dtype)
    n = kr * GRID_W
    o = (jnp.einsum('bhrqk,brkhd->brqhd', p[..., :n], vg)
         + jnp.einsum('bhrql,blhd->brqhd', p[..., n:], cv))
    return o.reshape(B, T, H * D)


def window_attn(q, k, v, ck, cv, sink):
    B, T, KV, G, D = q.shape
    nb = T // BLOCK
    qb = q.reshape(B, nb, BLOCK, KV, G, D)

    def band(x):
        xb = jnp.pad(x.reshape(B, nb, BLOCK, KV, D), ((0, 0), (1, 1), (0, 0), (0, 0), (0, 0)))
        return jnp.concatenate([xb[:, :-2], xb[:, 1:-1], xb[:, 2:]], axis=2)

    kb, vb = band(k), band(v)
    blk = jnp.arange(nb)[:, None]
    qpos = blk * BLOCK + jnp.arange(BLOCK)[None, :]
    kpos = (blk - 1) * BLOCK + jnp.arange(3 * BLOCK)[None, :]
    valid = ((jnp.abs(qpos[:, :, None] - kpos[:, None, :]) <= SWA_WINDOW)
             & (kpos[:, None, :] >= 0) & (kpos[:, None, :] < T))
    scale = D ** -0.5
    s = jnp.einsum('bnqkgd,bnskd->bnkgqs', qb, kb).astype(jnp.float32) * scale
    s = jnp.where(valid[None, :, None, None], s, NEG_INF)
    sc = jnp.einsum('bnqkgd,blkd->bnkgql', qb, ck).astype(jnp.float32) * scale
    sk = jnp.broadcast_to(sink.astype(jnp.float32)[None, None, :, :, None, None], s.shape[:-1] + (1,))
    p = jax.nn.softmax(jnp.concatenate([sk, s, sc], axis=-1), axis=-1).astype(v.dtype)
    nbk = 3 * BLOCK
    o = (jnp.einsum('bnkgqs,bnskd->bnqkgd', p[..., 1:1 + nbk], vb)
         + jnp.einsum('bnkgql,blkd->bnqkgd', p[..., 1 + nbk:], cv))
    return o.reshape(B, T, KV * G * D)


def merge_heads(oa, ob, g_a, g_b, w_out):
    return jnp.concatenate([rmsnorm(oa, g_a), rmsnorm(ob, g_b)], axis=-1) @ w_out


def conv_ffn(h, w_up, conv_w, conv_b, w_down):
    u = h @ w_up
    up = jnp.pad(u, ((0, 0), (1, 1), (0, 0)))
    u = up[:, :-2] * conv_w[0] + up[:, 1:-1] * conv_w[1] + up[:, 2:] * conv_w[2] + conv_b
    gate, val = jnp.split(u, 2, axis=-1)
    return (jax.nn.silu(gate) * val) @ w_down


def setup_inputs(seed: int = 0) -> dict:
    key = jax.random.key(seed)
    ks = jax.random.split(key, 24)
    nrm = lambda k, shape, s: jax.random.normal(k, shape, jnp.float32) * s
    gain = lambda k, shape: 1.0 + 0.01 * jax.random.normal(k, shape, jnp.float32)
    return {
        'x_prompt': nrm(ks[0], (BATCH, SEQ, D_MODEL), 1.0),
        'x_sample': nrm(ks[1], (DEC_BATCH, DEC_SEQ, D_MODEL), 1.0),
        'cache_a_k': nrm(ks[2], (DEC_BATCH, DEPTH, PAST_LEN, H_A, HEAD_DIM), 1.0),
        'cache_a_v': nrm(ks[3], (DEC_BATCH, DEPTH, PAST_LEN, H_A, HEAD_DIM), 1.0),
        'cache_b_k': nrm(ks[4], (DEC_BATCH, DEPTH, PAST_LEN, KV_B, HEAD_DIM), 1.0),
        'cache_b_v': nrm(ks[5], (DEC_BATCH, DEPTH, PAST_LEN, KV_B, HEAD_DIM), 1.0),
        'c': nrm(ks[6], (DEC_BATCH, D_MODEL), 1.0),
        'c_ctx': nrm(ks[7], (D_MODEL,), 1.0),
        'w_mod': nrm(ks[8], (DEPTH, D_MODEL, 6 * D_MODEL), 0.5 * D_MODEL ** -0.5),
        'b_mod': nrm(ks[9], (DEPTH, 6 * D_MODEL), 0.01),
        'g_mix_pre': gain(ks[10], (DEPTH, D_MODEL)),
        'g_mix_post': gain(ks[11], (DEPTH, D_MODEL)),
        'g_ffn_pre': gain(ks[12], (DEPTH, D_MODEL)),
        'g_ffn_post': gain(ks[13], (DEPTH, D_MODEL)),
        'w_in': nrm(ks[14], (DEPTH, D_MODEL, IN_WIDTH), D_MODEL ** -0.5),
        'rpb_a': nrm(ks[15], (DEPTH, H_A, 2 * NA_ROWS - 1, 2 * NA_COLS - 1), 0.1),
        'sink_b': nrm(ks[16], (DEPTH, KV_B, G_B), 0.5),
        'g_grp_a': gain(ks[17], (DEPTH, W_A)),
        'g_grp_b': gain(ks[18], (DEPTH, W_B)),
        'w_out': nrm(ks[19], (DEPTH, MIX_WIDTH, D_MODEL), MIX_WIDTH ** -0.5),
        'w_up': nrm(ks[20], (DEPTH, D_MODEL, 2 * D_FF), D_MODEL ** -0.5),
        'conv_w': nrm(ks[21], (DEPTH, 3, 2 * D_FF), 3 ** -0.5),
        'conv_b': nrm(ks[22], (DEPTH, 2 * D_FF), 0.01),
        'w_down': nrm(ks[23], (DEPTH, D_FF, D_MODEL), D_FF ** -0.5),
    }


def reference(x_prompt, x_sample, cache_a_k, cache_a_v, cache_b_k, cache_b_v, c, c_ctx,
              w_mod, b_mod, g_mix_pre, g_mix_post, g_ffn_pre, g_ffn_post, w_in, rpb_a, sink_b,
              g_grp_a, g_grp_b, w_out, w_up, conv_w, conv_b, w_down):
    xp = x_prompt
    xs = x_sample
    Bs, T, _ = x_sample.shape
    new_ak, new_av, new_bk, new_bv = [], [], [], []
    for l in range(DEPTH):
        sh1, sc1, gt1, sh2, sc2, gt2 = adaln(c_ctx[None], w_mod[l], b_mod[l])
        h = modulate(rmsnorm(xp, g_mix_pre[l]), sh1, sc1)
        qa, ka, va, qb, kb, vb = project(h, w_in[l])
        Bp, L = xp.shape[0], xp.shape[1]
        oa = ctx_self_attn(qa[:, :, :, None, :], ka, va, None)
        ob = ctx_self_attn(qb.reshape(Bp, L, KV_B, G_B, HEAD_DIM), kb, vb, sink_b[l])
        xp = xp + gt1 * rmsnorm(merge_heads(oa, ob, g_grp_a[l], g_grp_b[l], w_out[l]), g_mix_post[l])
        h = modulate(rmsnorm(xp, g_ffn_pre[l]), sh2, sc2)
        xp = xp + gt2 * rmsnorm(conv_ffn(h, w_up[l], conv_w[l], conv_b[l], w_down[l]), g_ffn_post[l])
        new_ak.append(ka)
        new_av.append(va)
        new_bk.append(kb)
        new_bv.append(vb)

        sh1, sc1, gt1, sh2, sc2, gt2 = adaln(c, w_mod[l], b_mod[l])
        h = modulate(rmsnorm(xs, g_mix_pre[l]), sh1, sc1)
        qa, ka, va, qb, kb, vb = project(h, w_in[l])
        qb = rope_2d(qb).reshape(Bs, T, KV_B, G_B, HEAD_DIM)
        kb = rope_2d(kb)
        oa = neighborhood_attn(qa, ka, va, cache_a_k[:, l], cache_a_v[:, l], rpb_a[l])
        ob = window_attn(qb, kb, vb, cache_b_k[:, l], cache_b_v[:, l], sink_b[l])
        xs = xs + gt1 * rmsnorm(merge_heads(oa, ob, g_grp_a[l], g_grp_b[l], w_out[l]), g_mix_post[l])
        h = modulate(rmsnorm(xs, g_ffn_pre[l]), sh2, sc2)
        xs = xs + gt2 * rmsnorm(conv_ffn(h, w_up[l], conv_w[l], conv_b[l], w_down[l]), g_ffn_post[l])
    new_a_k = jnp.stack(new_ak, axis=1)
    new_a_v = jnp.stack(new_av, axis=1)
    new_b_k = jnp.stack(new_bk, axis=1)
    new_b_v = jnp.stack(new_bv, axis=1)
    return (xp, xs, new_a_k, new_a_v, new_b_k, new_b_v)
```

```cpp
#include <hip/hip_runtime.h>
#include <hip/hip_cooperative_groups.h>
#include <cstdio>
#include <cstdint>
namespace cg = cooperative_groups;


namespace pg8 {
#define PG8_LAS __attribute__((address_space(3)))
typedef unsigned short bf16_t;
typedef short bf16x8 __attribute__((ext_vector_type(8)));
typedef float f32x4 __attribute__((ext_vector_type(4)));
typedef unsigned u32x4 __attribute__((ext_vector_type(4)));
constexpr int BM = 256, BK = 64, HALF = 128, HTB = HALF * BK * 2  , STAGE_BYTES = 8 * HTB, NXCD = 8, WGM = 8;

__host__ __device__ __forceinline__ int lds_byte(int r, int c) { const int st = (r >> 4) * 2 + (c >> 5), rr = r & 15, cc = c & 31, ob = rr * 64 + cc * 2; return st * 1024 + (ob ^ (((ob >> 9) & 1) << 5)); }
__host__ __device__ __forceinline__ void stage_rc(int b, int& R, int& C) { const int st = b / 1024, sb = b % 1024, swz = sb ^ (((sb >> 9) & 1) << 5); R = (st >> 1) * 16 + swz / 64; C = (st & 1) * 32 + (swz % 64) / 2; }
__host__ __device__ __forceinline__ int perm32(int rho) { const int n = rho >> 4, i = rho & 15; return 8 * (i >> 2) + 4 * n + (i & 3); }

struct Unit { int pm, pn; };
struct Gemm { const bf16_t* A; const bf16_t* Bt; int K, lda, nsplit, a_coloff, seg; const unsigned* kflags; int kwait_t; };

struct StaticOrder {
    int nM, nN, nwg, G, c;
    __host__ __device__ void init(int M, int N, int G_, int c_) { nM = M / BM; nN = N / BM; nwg = nM * nN; G = G_; c = c_; }
    __host__ __device__ bool next(int i, Unit& u) const {
        const long L = (long)i * G + c; if (L >= nwg) return false;
        int wgid = (int)L; { const int q = nwg / NXCD, r = nwg % NXCD, xcd = wgid % NXCD, off = wgid / NXCD; wgid = (xcd < r ? xcd * (q + 1) : r * (q + 1) + (xcd - r) * q) + off; }
        const int nig = WGM * nN, gid = wgid / nig, fm = gid * WGM, gsz = (nM - fm) < WGM ? (nM - fm) : WGM;
        u.pm = fm + ((wgid % nig) % gsz); u.pn = (wgid % nig) / gsz; return true;
    }
    __device__ __forceinline__ void a_ready(const Unit&) const {}
    __device__ __forceinline__ void done(const Unit&) const {}
};

template <class Epi, class Sched, bool ALIGN_EPI = false, bool SP2 = false>
__device__ __forceinline__ void gemm_phase(PG8_LAS unsigned char* lds, const Gemm g, const Sched& S, const Epi& E) {
    int tid_ = threadIdx.x; asm volatile("" : "+v"(tid_));
    const int tid = tid_, wid = __builtin_amdgcn_readfirstlane(tid >> 6), lane = tid & 63, wr = wid >> 2, wc = wid & 3, fr = lane & 15, fq = lane >> 4;
    const int K = g.K, nt = K / BK;
    unsigned voffA[2], voffB[2];
#pragma unroll
    for (int i = 0; i < 2; ++i) { int R, C; stage_rc(tid * 16 + i * 8192, R, C); const int Rb = Epi::PERM ? ((R & ~31) + perm32(R & 31)) : R;
        const int Ra = g.seg ? 62 * (R >> 6) + (R & 63) : R; voffA[i] = (unsigned)(Ra * g.lda + C) * 2u; voffB[i] = (unsigned)(Rb * K + C) * 2u; }
    const size_t kstep = (size_t)(BK * 2);
    const size_t hstep = (size_t)HALF * K * 2;
    const size_t tstep = 2 * hstep;
    const size_t ahs = (size_t)(g.seg ? 124 : 128) * g.lda * 2, ats = 2 * ahs;
#define PG8_APTR(u) ((const char*)g.A + (size_t)(u).pm * ats - (g.seg ? (size_t)g.lda * 2 : 0) + ((u).pn >= g.nsplit ? (size_t)g.a_coloff : 0))
    const unsigned ldsw = (unsigned)wid * 1024u;
    const int aoff = lds_byte(wr * 64 + fr, fq * 8), boff = lds_byte(wc * 32 + fr, fq * 8);
#define PG8_SA(b, h) (((b) * 2 + (h)) * HTB)
#define PG8_SB(b, h) ((4 + (b) * 2 + (h)) * HTB)
#define PG8_STAGE(bufoff, gbase, voff) do { _Pragma("unroll") for (int _i = 0; _i < 2; ++_i) \
        __builtin_amdgcn_global_load_lds((const unsigned*)((const char*)(gbase) + (voff)[_i]), (PG8_LAS unsigned*)(lds + (bufoff) + ldsw + _i * 8192), 16, 0, 0); } while (0)
#define PG8_LDA(dst, b, h) do { _Pragma("unroll") for (int m = 0; m < 4; ++m) _Pragma("unroll") for (int k = 0; k < 2; ++k) dst[m][k] = *(const PG8_LAS bf16x8*)(lds + PG8_SA(b, h) + aoff + m * 2048 + k * 1024); } while (0)
#define PG8_LDB(dst, b, h) do { _Pragma("unroll") for (int n = 0; n < 2; ++n) _Pragma("unroll") for (int k = 0; k < 2; ++k) dst[n][k] = *(const PG8_LAS bf16x8*)(lds + PG8_SB(b, h) + boff + n * 2048 + k * 1024); } while (0)
#define PG8_MMA(ai, bj, At, Bt) do { __builtin_amdgcn_s_setprio(1); _Pragma("unroll") for (int m = 0; m < 4; ++m) _Pragma("unroll") for (int n = 0; n < 2; ++n) _Pragma("unroll") for (int k = 0; k < 2; ++k) \
        acc[ai][bj][m][n] = __builtin_amdgcn_mfma_f32_16x16x32_bf16(Bt[n][k], At[m][k], acc[ai][bj][m][n], 0, 0, 0); __builtin_amdgcn_s_setprio(0); } while (0)
#define PG8_WAIT_V(n) asm volatile("s_waitcnt vmcnt(" #n ")" ::: "memory")
#define PG8_WAIT_L(n) asm volatile("s_waitcnt lgkmcnt(" #n ")" ::: "memory")
#define PG8_BAR __builtin_amdgcn_s_barrier()
#define PG8_SCHED __builtin_amdgcn_sched_barrier(0)
    Unit cur, nxt; int ui = 0;
    if (!S.next(0, cur)) return;
    f32x4 acc[2][2][4][2];
#pragma unroll
    for (int a = 0; a < 2; ++a)
#pragma unroll
        for (int b = 0; b < 2; ++b)
#pragma unroll
            for (int m = 0; m < 4; ++m)
#pragma unroll
                for (int n = 0; n < 2; ++n) acc[a][b][m][n] = (f32x4){0.f, 0.f, 0.f, 0.f};
    bf16x8 At[4][2], B0[2][2], B1[2][2];
    const char* cA = PG8_APTR(cur); const char* cB = (const char*)g.Bt + (size_t)cur.pn * tstep;
    S.a_ready(cur);
    if constexpr (SP2) {
        PG8_STAGE(PG8_SB(0, 0), cB, voffB); PG8_STAGE(PG8_SB(0, 1), cB + hstep, voffB); PG8_STAGE(PG8_SA(0, 0), cA, voffA); PG8_STAGE(PG8_SA(0, 1), cA + ahs, voffA);
        if (wr == 1) PG8_BAR;
        PG8_WAIT_V(2); PG8_BAR;
        PG8_STAGE(PG8_SB(1, 0), cB + kstep, voffB); PG8_STAGE(PG8_SA(1, 0), cA + kstep, voffA); PG8_STAGE(PG8_SB(1, 1), cB + hstep + kstep, voffB);
        PG8_WAIT_V(6); PG8_BAR;
    } else {
        PG8_STAGE(PG8_SB(0, 0), cB, voffB); PG8_STAGE(PG8_SA(0, 0), cA, voffA); PG8_STAGE(PG8_SB(0, 1), cB + hstep, voffB); PG8_STAGE(PG8_SA(0, 1), cA + ahs, voffA);
        if (wr == 1) PG8_BAR;
        PG8_WAIT_V(4); PG8_BAR;
        PG8_STAGE(PG8_SB(1, 0), cB + kstep, voffB); PG8_STAGE(PG8_SA(1, 0), cA + kstep, voffA); PG8_STAGE(PG8_SB(1, 1), cB + hstep + kstep, voffB);
        PG8_WAIT_V(6); PG8_BAR;
    }
    for (;;) {
        const bool has_next = S.next(ui + 1, nxt);
        const char* nA = has_next ? PG8_APTR(nxt) : cA; const char* nB = has_next ? (const char*)g.Bt + (size_t)nxt.pn * tstep : cB;
        for (int t = 0; t < nt; t += 2) {
            if (g.kflags && t == g.kwait_t) {
                const int pd_ = cur.pm, ks_ = cur.pn >> 2, p0_ = (256 * pd_) / 248, p1_ = (256 * pd_ + 255) / 248;
                for (int pp_ = p0_; pp_ <= p1_; ++pp_) if (pp_ < 19) { const unsigned* f_ = g.kflags + (pp_ * 2 + ks_) * 64; unsigned sp_ = 0;
                    while (__hip_atomic_load(f_, __ATOMIC_RELAXED, __HIP_MEMORY_SCOPE_AGENT) == 0u) { __builtin_amdgcn_s_sleep(2); if (++sp_ > (1u << 22)) break; } }
                __builtin_amdgcn_fence(__ATOMIC_ACQUIRE, "agent");
            }
            const bool last = (t == nt - 2);
            const char* a1 = cA + (size_t)(t + 1) * kstep;
            const char* a2 = last ? nA : cA + (size_t)(t + 2) * kstep; const char* b2 = last ? nB : cB + (size_t)(t + 2) * kstep;
            const char* a3 = a2 + kstep; const char* b3 = b2 + kstep;
            if (last && has_next) S.a_ready(nxt);
            if constexpr (SP2) {
            PG8_LDB(B0, 0, 0); PG8_LDB(B1, 0, 1); PG8_SCHED; PG8_LDA(At, 0, 0); PG8_STAGE(PG8_SA(1, 1), a1 + ahs, voffA);
            PG8_WAIT_V(8); PG8_WAIT_L(0); PG8_BAR; PG8_MMA(0, 0, At, B0); PG8_MMA(0, 1, At, B1); PG8_BAR; PG8_SCHED;
            PG8_LDA(At, 0, 1); PG8_STAGE(PG8_SB(0, 0), b2, voffB); PG8_STAGE(PG8_SB(0, 1), b2 + hstep, voffB); PG8_STAGE(PG8_SA(0, 0), a2, voffA);
            PG8_WAIT_V(8); PG8_WAIT_L(0); PG8_BAR; PG8_MMA(1, 0, At, B0); PG8_MMA(1, 1, At, B1); PG8_BAR; PG8_SCHED;
            PG8_LDB(B0, 1, 0); PG8_LDB(B1, 1, 1); PG8_SCHED; PG8_LDA(At, 1, 0); PG8_STAGE(PG8_SA(0, 1), a2 + ahs, voffA);
            PG8_WAIT_V(8); PG8_WAIT_L(0); PG8_BAR; PG8_MMA(0, 0, At, B0); PG8_MMA(0, 1, At, B1); PG8_BAR; PG8_SCHED;
            PG8_LDA(At, 1, 1); PG8_STAGE(PG8_SB(1, 0), b3, voffB); PG8_STAGE(PG8_SB(1, 1), b3 + hstep, voffB); PG8_STAGE(PG8_SA(1, 0), a3, voffA);
            PG8_WAIT_V(8); PG8_WAIT_L(0); PG8_BAR; PG8_MMA(1, 0, At, B0); PG8_MMA(1, 1, At, B1); PG8_BAR; PG8_SCHED;
            } else {
            PG8_LDB(B0, 0, 0); PG8_SCHED; PG8_LDA(At, 0, 0); PG8_STAGE(PG8_SA(1, 1), a1 + ahs, voffA);
            PG8_WAIT_L(8); PG8_BAR; PG8_WAIT_L(0); PG8_MMA(0, 0, At, B0); PG8_BAR; PG8_SCHED;
            PG8_LDB(B1, 0, 1); PG8_STAGE(PG8_SB(0, 0), b2, voffB);
            PG8_BAR; PG8_WAIT_L(0); PG8_MMA(0, 1, At, B1); PG8_BAR;
            PG8_LDA(At, 0, 1); PG8_STAGE(PG8_SA(0, 0), a2, voffA);
            PG8_BAR; PG8_WAIT_L(0); PG8_MMA(1, 0, At, B0); PG8_BAR; PG8_SCHED;
            PG8_STAGE(PG8_SB(0, 1), b2 + hstep, voffB);
            PG8_WAIT_V(6); PG8_BAR; PG8_MMA(1, 1, At, B1); PG8_BAR;
            PG8_LDB(B0, 1, 0); PG8_SCHED; PG8_LDA(At, 1, 0); PG8_STAGE(PG8_SA(0, 1), a2 + ahs, voffA);
            PG8_WAIT_L(8); PG8_BAR; PG8_WAIT_L(0); PG8_MMA(0, 0, At, B0); PG8_BAR; PG8_SCHED;
            PG8_LDB(B1, 1, 1); PG8_STAGE(PG8_SB(1, 0), b3, voffB);
            PG8_BAR; PG8_WAIT_L(0); PG8_MMA(0, 1, At, B1); PG8_BAR;
            PG8_LDA(At, 1, 1); PG8_STAGE(PG8_SA(1, 0), a3, voffA);
            PG8_BAR; PG8_WAIT_L(0); PG8_MMA(1, 0, At, B0); PG8_BAR; PG8_SCHED;
            PG8_STAGE(PG8_SB(1, 1), b3 + hstep, voffB);
            PG8_WAIT_V(6); PG8_BAR; PG8_MMA(1, 1, At, B1); PG8_BAR;
            }
        }
        if constexpr (ALIGN_EPI) { if (wr == 0) PG8_BAR; }
        if constexpr (!Epi::AFTER_DRAIN) { E(acc, cur, wr, wc, fr, fq); S.done(cur); }
        if (!has_next) break;
#pragma unroll
        for (int a = 0; a < 2; ++a)
#pragma unroll
            for (int b = 0; b < 2; ++b)
#pragma unroll
                for (int m = 0; m < 4; ++m)
#pragma unroll
                    for (int n = 0; n < 2; ++n) acc[a][b][m][n] = (f32x4){0.f, 0.f, 0.f, 0.f};
        cur = nxt; cA = nA; cB = nB; ++ui;
        if constexpr (ALIGN_EPI) { if (wr == 1) PG8_BAR; }
    }
    PG8_WAIT_V(0);
    if constexpr (!ALIGN_EPI) { if (wr == 0) PG8_BAR; }
    PG8_BAR;
    if constexpr (Epi::AFTER_DRAIN) { E.fused(acc, cur, wr, wc, fr, fq, lds, wid, lane); S.done(cur); }
#undef PG8_APTR
#undef PG8_SA
#undef PG8_SB
#undef PG8_STAGE
#undef PG8_LDA
#undef PG8_LDB
#undef PG8_MMA
#undef PG8_WAIT_V
#undef PG8_WAIT_L
#undef PG8_BAR
#undef PG8_SCHED
}
}

#define DI __device__ __forceinline__
#define LAS __attribute__((address_space(3)))
typedef unsigned short bf16_t;
typedef short bf16x8 __attribute__((ext_vector_type(8)));
typedef short s16x4 __attribute__((ext_vector_type(4)));
typedef float f32x4 __attribute__((ext_vector_type(4)));
typedef float f32x2 __attribute__((ext_vector_type(2)));
typedef unsigned u32x4 __attribute__((ext_vector_type(4)));
typedef unsigned u32x2 __attribute__((ext_vector_type(2)));
typedef __bf16 bf2_t __attribute__((ext_vector_type(2)));

constexpr int NTOK = 6144, NPROMPT = 4096, DM = 1024, INW = 2304, DFF = 2816, UPW = 5632;
constexpr int NTHR = 512, NWAVE = 8;
constexpr float EPS = 1e-6f;

constexpr size_t OFF_BAR = 0;
constexpr size_t OFF_MOD = 65536;
constexpr size_t OFF_WIN = 1u << 20;
constexpr size_t OFF_WOUT = OFF_WIN + (size_t)2304 * 1024 * 2;
constexpr size_t OFF_WUP = OFF_WOUT + (size_t)1024 * 1024 * 2;
constexpr size_t OFF_WDOWN = OFF_WUP + (size_t)5632 * 1024 * 2;
constexpr size_t OFF_CAK = OFF_WDOWN + (size_t)1024 * 2816 * 2;
constexpr size_t OFF_CAV = OFF_CAK + (size_t)2 * 256 * 512 * 2;
constexpr size_t OFF_CBK = OFF_CAV + (size_t)2 * 256 * 512 * 2;
constexpr size_t OFF_CBV = OFF_CBK + (size_t)2 * 256 * 128 * 2;
constexpr size_t OFF_H = OFF_CBV + (size_t)2 * 256 * 128 * 2;
constexpr size_t OFF_Z = OFF_H + (size_t)NTOK * 1024 * 2;
constexpr size_t OFF_O = OFF_Z + (size_t)NTOK * 2304 * 2;
constexpr size_t OFF_SS = OFF_O + (size_t)NTOK * 1024 * 2;
constexpr size_t OFF_MIX = OFF_SS + (size_t)NTOK * 16 * 4;
constexpr size_t OFF_ACT = OFF_MIX + (size_t)2 * NTOK * 1024 * 4;
constexpr size_t WS_END = OFF_ACT + (size_t)NTOK * 2816 * 2;

constexpr size_t OUT_Y = 0, OUT_AK = (size_t)NTOK * 1024, OUT_AV = OUT_AK + (size_t)NPROMPT * 512, OUT_BK = OUT_AV + (size_t)NPROMPT * 512, OUT_BV = OUT_BK + (size_t)NPROMPT * 128;

struct P {
    const float* in[24];
    float* out;
    unsigned char* ws;
};
enum { I_XP = 0, I_XS, I_CAK, I_CAV, I_CBK, I_CBV, I_C, I_CCTX, I_WMOD, I_BMOD, I_GMIXPRE, I_GMIXPOST, I_GFFNPRE, I_GFFNPOST, I_WIN, I_RPB, I_SINK, I_GGA, I_GGB, I_WOUT, I_WUP, I_CONVW, I_CONVB, I_WDOWN };

constexpr int LDS_MAIN = 131072;
constexpr int LDS_BYTES = LDS_MAIN + 256;
constexpr int LDP = 72;

DI unsigned pk_bf16(float lo, float hi) { f32x2 v = {lo, hi}; bf2_t r = __builtin_convertvector(v, bf2_t); return __builtin_bit_cast(unsigned, r); }
DI float wave_sum(float v) {
#pragma unroll
    for (int o = 1; o < 64; o <<= 1) v += __shfl_xor(v, o);
    return v;
}
DI float silu_f(float x) { return x * __builtin_amdgcn_rcpf(1.f + __builtin_amdgcn_exp2f(x * -1.4426950408889634f)); }
DI const float* xrow_ptr(const P& p, int row) { return row < NPROMPT ? p.in[I_XP] + (size_t)row * DM : p.in[I_XS] + (size_t)(row - NPROMPT) * DM; }
DI int cond_of(int row) { return row < NPROMPT ? 0 : 1 + ((row - NPROMPT) >> 10); }
DI float dot4(f32x4 a) { return (a.x * a.x + a.y * a.y) + (a.z * a.z + a.w * a.w); }
DI float hsum4(f32x4 a) { return (a.x + a.y) + (a.z + a.w); }
#define XB_TMO      128
#define XB_XCNT(j)  (256  + 64 * (j))
#define XB_XSUB(j)  (1280 + 64 * (j))
#define XB_XGEN(j)  (2304 + 64 * (j))
#define XB_TOP      3328
#define XB_TOPGEN   3392
#define XCD_BAR_WORDS 3456
#define XB_SPIN_CAP (1u << 18)

__device__ __forceinline__ unsigned xb_ld(unsigned* p)              { return __hip_atomic_load(p, __ATOMIC_RELAXED, __HIP_MEMORY_SCOPE_AGENT); }
__device__ __forceinline__ unsigned xb_add(unsigned* p, unsigned v) { return __hip_atomic_fetch_add(p, v, __ATOMIC_RELAXED, __HIP_MEMORY_SCOPE_AGENT); }
__device__ __forceinline__ unsigned xb_xcc_id() { return (unsigned)__builtin_amdgcn_s_getreg((3 << 11) | 20) & 0xFu; }
#define XB_SPIN(cond, bar) do { unsigned _sp = 0; while (cond) { __builtin_amdgcn_s_sleep(1); \
    if ((++_sp & 255u) == 0u) { if (xb_ld(&(bar)[XB_TMO])) break; if (_sp > XB_SPIN_CAP) { atomicAdd(&(bar)[XB_TMO], 1u); break; } } } } while (0)

struct XcdBarrier {
    unsigned* bar; unsigned x;
    volatile LAS unsigned* st;
};

__device__ __forceinline__ XcdBarrier xcd_barrier_post(unsigned* bar, volatile LAS unsigned* st) {
    XcdBarrier b; b.bar = bar; b.x = xb_xcc_id(); b.st = st;
    if (threadIdx.x == 0) (void)xb_add(&bar[XB_XCNT(b.x)], 1u);
    return b;
}
__device__ __forceinline__ void xcd_barrier_complete(unsigned* bar, unsigned x, unsigned& nloc, unsigned& nx) {
    const unsigned G = gridDim.x * gridDim.y * gridDim.z;
    unsigned sum, cnt, mine, sp = 0u;
    for (;;) {
        sum = 0u; cnt = 0u; mine = 0u;
#pragma unroll
        for (unsigned j = 0; j < 16; ++j) { const unsigned c = xb_ld(&bar[XB_XCNT(j)]); sum += c; cnt += (c > 0u) ? 1u : 0u; mine = (j == x) ? c : mine; }
        if (sum == G) break;
        __builtin_amdgcn_s_sleep(1);
        if ((++sp & 255u) == 0u) { if (xb_ld(&bar[XB_TMO])) break; if (sp > XB_SPIN_CAP) { atomicAdd(&bar[XB_TMO], 1u); break; } }
    }
    nloc = mine > 0u ? mine : 1u; nx = cnt > 0u ? cnt : 1u;
}

__device__ __forceinline__ void xcd_barrier(const XcdBarrier& b) {
    asm volatile("s_waitcnt vmcnt(0)" ::: "memory");
    __syncthreads();
    if (threadIdx.x == 0) {
        unsigned* bar = b.bar;
        __builtin_amdgcn_s_waitcnt(0);
        unsigned nloc = b.st[0], nx = b.st[1];
        if (nloc == 0u) { xcd_barrier_complete(bar, b.x, nloc, nx); b.st[0] = nloc; b.st[1] = nx; }
        const unsigned old = xb_add(&bar[XB_XSUB(b.x)], 1u);
        const unsigned gen = old / nloc;
        if (old + 1u == (gen + 1u) * nloc) {
            __builtin_amdgcn_fence(__ATOMIC_RELEASE, "agent");
            asm volatile("s_waitcnt vmcnt(0)" ::: "memory");
            const unsigned og = xb_add(&bar[XB_TOP], 1u);
            const unsigned tg = og / nx;
            if (og + 1u == (tg + 1u) * nx) xb_add(&bar[XB_TOPGEN], 1u);
            else XB_SPIN(xb_ld(&bar[XB_TOPGEN]) == tg, bar);
            __builtin_amdgcn_fence(__ATOMIC_ACQUIRE, "agent");
            xb_add(&bar[XB_XGEN(b.x)], 1u);
            asm volatile("s_waitcnt vmcnt(0)" ::: "memory");
        } else {
            XB_SPIN(xb_ld(&bar[XB_XGEN(b.x)]) == gen, bar);
            __builtin_amdgcn_fence(__ATOMIC_ACQUIRE, "agent");
            asm volatile("s_waitcnt vmcnt(0)" ::: "memory");
        }
    }
    __syncthreads();
}

DI void p0_adaln(const P& p, int item, float* scr, int tid) {
    const int lane = tid & 63, w = tid >> 6;
    const int c4 = (tid & 7) * 4, rg = tid >> 3;
    const int col = item * 32 + c4;
    const float* wm = p.in[I_WMOD]; const float* cctx = p.in[I_CCTX]; const float* c = p.in[I_C];
    f32x4 wv[16];
#pragma unroll
    for (int i = 0; i < 16; ++i) wv[i] = __builtin_nontemporal_load((const f32x4*)(wm + (size_t)(rg + 64 * i) * 6144 + col));
    f32x4 a0 = {0, 0, 0, 0}, a1 = {0, 0, 0, 0}, a2 = {0, 0, 0, 0};
#pragma unroll
    for (int i = 0; i < 16; ++i) {
        const int row = rg + 64 * i;
        const float s0 = silu_f(cctx[row]), s1 = silu_f(c[row]), s2 = silu_f(c[1024 + row]);
        a0 += wv[i] * s0; a1 += wv[i] * s1; a2 += wv[i] * s2;
    }
#pragma unroll
    for (int o = 8; o < 64; o <<= 1) {
#pragma unroll
        for (int e = 0; e < 4; ++e) { a0[e] += __shfl_xor(a0[e], o); a1[e] += __shfl_xor(a1[e], o); a2[e] += __shfl_xor(a2[e], o); }
    }
    if (lane < 8) { *(f32x4*)(scr + (w * 3 + 0) * 32 + c4) = a0; *(f32x4*)(scr + (w * 3 + 1) * 32 + c4) = a1; *(f32x4*)(scr + (w * 3 + 2) * 32 + c4) = a2; }
    __syncthreads();
    if (tid < 96) {
        const int cond = tid >> 5, cc = tid & 31; float s = 0.f;
#pragma unroll
        for (int ww = 0; ww < 8; ++ww) s += scr[(ww * 3 + cond) * 32 + cc];
        __hip_atomic_store((float*)(p.ws + OFF_MOD) + cond * 6144 + item * 32 + cc, s + p.in[I_BMOD][item * 32 + cc], __ATOMIC_RELAXED, __HIP_MEMORY_SCOPE_AGENT);
    }
    __syncthreads();
}
DI void p0_transpose(const float* W, int N, int srcA, int srcB, int k0, bf16_t* WT, int outrow0, int outK, int outk0, const float* ks, float* scr, int tid) {
    const int c4 = (tid & 63) * 4, r0 = tid >> 6;
    const int scol = c4 < 128 ? srcA + c4 : srcB + (c4 - 128);
    f32x4 v[8];
#pragma unroll
    for (int i = 0; i < 8; ++i) v[i] = *(const f32x4*)(W + (size_t)(k0 + r0 + 8 * i) * N + scol);
#pragma unroll
    for (int i = 0; i < 8; ++i) { if (ks) v[i] *= ks[k0 + r0 + 8 * i]; *(f32x4*)(scr + (r0 + 8 * i) * 260 + c4) = v[i]; }
    __syncthreads();
    const int n = tid >> 1, kh = (tid & 1) * 32;
    const float* s = scr + kh * 260 + n;
#pragma unroll
    for (int q = 0; q < 4; ++q) {
        u32x4 o;
        o.x = pk_bf16(s[(8 * q + 0) * 260], s[(8 * q + 1) * 260]); o.y = pk_bf16(s[(8 * q + 2) * 260], s[(8 * q + 3) * 260]);
        o.z = pk_bf16(s[(8 * q + 4) * 260], s[(8 * q + 5) * 260]); o.w = pk_bf16(s[(8 * q + 6) * 260], s[(8 * q + 7) * 260]);
        *(u32x4*)(WT + (size_t)(outrow0 + n) * outK + outk0 + kh + 8 * q) = o;
    }
    __syncthreads();
}
DI void publish_inc(unsigned* cnt, int tid) {
    asm volatile("s_waitcnt vmcnt(0)" ::: "memory");
    __syncthreads();
    if (tid == 0) { __builtin_amdgcn_fence(__ATOMIC_RELEASE, "agent"); asm volatile("s_waitcnt vmcnt(0)" ::: "memory"); (void)xb_add(cnt, 1u); }
}
DI void publish_inc_wt(unsigned* cnt, int tid) {
    asm volatile("s_waitcnt vmcnt(0)" ::: "memory");
    __syncthreads();
    if (tid == 0) (void)xb_add(cnt, 1u);
}
DI void wait_count(unsigned* cnt, unsigned want, int tid) {
    if (tid == 0) {
        unsigned sp = 0; while (xb_ld(cnt) < want) { __builtin_amdgcn_s_sleep(2); if (++sp > (1u << 22)) break; }
        __builtin_amdgcn_fence(__ATOMIC_ACQUIRE, "agent"); asm volatile("s_waitcnt vmcnt(0)" ::: "memory");
    }
    __syncthreads();
}
constexpr int T_IN = 144, T_OUT = 64, T_UP = 352, T_DOWN = 176;
DI void tr_win(const P& p, int r, float* scr, int tid) { const int kb = r / 9, nbk = r % 9; p0_transpose(p.in[I_WIN], INW, nbk * 256, nbk * 256 + 128, kb * 64, (bf16_t*)(p.ws + OFF_WIN), nbk * 256, 1024, kb * 64, nullptr, scr, tid); }
DI void tr_wout(const P& p, int r, float* scr, int tid) { const int kb = r >> 2, nbk = r & 3, half = kb >> 3;
    p0_transpose(p.in[I_WOUT], 1024, nbk * 256, nbk * 256 + 128, kb * 64, (bf16_t*)(p.ws + OFF_WOUT), half * 1024 + nbk * 256, 512, (kb & 7) * 64, half ? p.in[I_GGB] - 512 : p.in[I_GGA], scr, tid); }
DI void tr_wup(const P& p, int r, float* scr, int tid) { const int kb = r / 22, tl = r % 22; p0_transpose(p.in[I_WUP], UPW, tl * 128, DFF + tl * 128, kb * 64, (bf16_t*)(p.ws + OFF_WUP), tl * 256, 1024, kb * 64, nullptr, scr, tid); }
DI void tr_wdown(const P& p, int r, float* scr, int tid) { const int kb = r >> 2, nbk = r & 3, sp = kb / 22;
    p0_transpose(p.in[I_WDOWN], 1024, nbk * 256, nbk * 256 + 128, kb * 64, (bf16_t*)(p.ws + OFF_WDOWN), sp * 1024 + nbk * 256, 1408, (kb - 22 * sp) * 64, nullptr, scr, tid); }
struct TrDesc { const float* W; const float* ks; bf16_t* WT; int N, srcA, srcB, k0, outrow0, outK, outk0; };
DI TrDesc tr_desc(const P& p, int r) {
    TrDesc d; d.ks = nullptr;
    if (r < T_IN) { const int kb = r / 9, nbk = r % 9; d.W = p.in[I_WIN]; d.N = INW; d.srcA = nbk * 256; d.srcB = nbk * 256 + 128; d.k0 = kb * 64; d.WT = (bf16_t*)(p.ws + OFF_WIN); d.outrow0 = nbk * 256; d.outK = 1024; d.outk0 = kb * 64; return d; }
    r -= T_IN;
    if (r < T_OUT) { const int kb = r >> 2, nbk = r & 3, half = kb >> 3; d.W = p.in[I_WOUT]; d.N = 1024; d.srcA = nbk * 256; d.srcB = nbk * 256 + 128; d.k0 = kb * 64; d.WT = (bf16_t*)(p.ws + OFF_WOUT); d.outrow0 = half * 1024 + nbk * 256; d.outK = 512; d.outk0 = (kb & 7) * 64;
        d.ks = half ? p.in[I_GGB] - 512 : p.in[I_GGA]; return d; }
    r -= T_OUT;
    if (r < T_UP) { const int kb = r / 22, tl = r % 22; d.W = p.in[I_WUP]; d.N = UPW; d.srcA = tl * 128; d.srcB = DFF + tl * 128; d.k0 = kb * 64; d.WT = (bf16_t*)(p.ws + OFF_WUP); d.outrow0 = tl * 256; d.outK = 1024; d.outk0 = kb * 64; return d; }
    r -= T_UP;
    { const int kb = r >> 2, nbk = r & 3, sp = kb / 22; d.W = p.in[I_WDOWN]; d.N = 1024; d.srcA = nbk * 256; d.srcB = nbk * 256 + 128; d.k0 = kb * 64; d.WT = (bf16_t*)(p.ws + OFF_WDOWN); d.outrow0 = sp * 1024 + nbk * 256; d.outK = 1408; d.outk0 = (kb - 22 * sp) * 64; return d; }
}
DI void tr_load(const TrDesc& d, f32x4 (&v)[8], int tid) {
    const int c4 = (tid & 63) * 4, r0 = tid >> 6; const int scol = c4 < 128 ? d.srcA + c4 : d.srcB + (c4 - 128);
#pragma unroll
    for (int i = 0; i < 8; ++i) { v[i] = __builtin_nontemporal_load((const f32x4*)(d.W + (size_t)(d.k0 + r0 + 8 * i) * d.N + scol)); }
}
DI void tr_range(const P& p, int first, int end, int stride, float* scr, int tid) {
    if (first >= end) return;
    f32x4 v[8];
    TrDesc d = tr_desc(p, first);
    tr_load(d, v, tid);
    for (int it = first; it < end; it += stride) {
        const int c4 = (tid & 63) * 4, r0 = tid >> 6;
#pragma unroll
        for (int i = 0; i < 8; ++i) { f32x4 t = v[i]; if (d.ks) t *= d.ks[d.k0 + r0 + 8 * i]; *(f32x4*)(scr + (r0 + 8 * i) * 260 + c4) = t; }
        const TrDesc cur = d;
        if (it + stride < end) { d = tr_desc(p, it + stride); tr_load(d, v, tid); }
        __syncthreads();
        const int n = tid >> 1, kh = (tid & 1) * 32;
        const float* sp = scr + kh * 260 + n;
#pragma unroll
        for (int q = 0; q < 4; ++q) {
            u32x4 o;
            o.x = pk_bf16(sp[(8 * q + 0) * 260], sp[(8 * q + 1) * 260]); o.y = pk_bf16(sp[(8 * q + 2) * 260], sp[(8 * q + 3) * 260]);
            o.z = pk_bf16(sp[(8 * q + 4) * 260], sp[(8 * q + 5) * 260]); o.w = pk_bf16(sp[(8 * q + 6) * 260], sp[(8 * q + 7) * 260]);
            *(u32x4*)(cur.WT + (size_t)(cur.outrow0 + n) * cur.outK + cur.outk0 + kh + 8 * q) = o;
        }
        __syncthreads();
    }
}
DI void p0_phase(const P& p, int bid, int nb, float* scr, int tid, unsigned* cntA) {
    constexpr int T_AD = 192, N_CV = 80;
    constexpr int NITEMS = T_AD + N_CV;
    for (int it = bid; it < NITEMS; it += nb) {
        int r = it;
        if (r < T_AD) { p0_adaln(p, r, scr, tid); if (r < 64) publish_inc_wt(cntA, tid); continue; }
        r -= T_AD;
        {
            const size_t e0 = (size_t)r * 8192;
#pragma unroll
            for (int i = 0; i < 2; ++i) {
                const size_t e = e0 + (size_t)(i * NTHR + tid) * 8;
                const float* src; bf16_t* dst;
                if (e < 262144) { src = p.in[I_CAK] + e; dst = (bf16_t*)(p.ws + OFF_CAK) + e; }
                else if (e < 524288) { src = p.in[I_CAV] + (e - 262144); dst = (bf16_t*)(p.ws + OFF_CAV) + (e - 262144); }
                else if (e < 589824) { src = p.in[I_CBK] + (e - 524288); dst = (bf16_t*)(p.ws + OFF_CBK) + (e - 524288); }
                else { src = p.in[I_CBV] + (e - 589824); dst = (bf16_t*)(p.ws + OFF_CBV) + (e - 589824); }
                const f32x4 a = *(const f32x4*)src, b = *(const f32x4*)(src + 4);
                u32x4 o; o.x = pk_bf16(a.x, a.y); o.y = pk_bf16(a.z, a.w); o.z = pk_bf16(b.x, b.y); o.w = pk_bf16(b.z, b.w);
                *(u32x4*)dst = o;
            }
        }
    }
    __syncthreads();
    if (nb == 256) { if (bid >= 192) tr_range(p, bid - 192, T_IN, 64, scr, tid); }
    else tr_range(p, bid, T_IN, nb, scr, tid);
}

DI f32x4 ld_bf4(const bf16_t* p) { const u32x2 r = *(const u32x2*)p; f32x4 o; o.x = __uint_as_float(r.x << 16); o.y = __uint_as_float(r.x & 0xffff0000u); o.z = __uint_as_float(r.y << 16); o.w = __uint_as_float(r.y & 0xffff0000u); return o; }
template <int RP> DI void p1_rows(const P& p, const int gw, const int ngw, const int rend, const int lane, unsigned* waitcnt = nullptr, int tid = 0) {
    bf16_t* H = (bf16_t*)(p.ws + OFF_H);
    for (int row0 = gw; row0 < rend; row0 += RP * ngw) {
        f32x4 v[RP][4];
#pragma unroll
        for (int k = 0; k < RP; ++k) { const int row = row0 + k * ngw; if (row < rend) { const float* x = xrow_ptr(p, row);
#pragma unroll
            for (int j = 0; j < 4; ++j) v[k][j] = __builtin_nontemporal_load((const f32x4*)(x + 4 * lane + 256 * j)); } }
        if (waitcnt) { wait_count(waitcnt, 64u, tid); waitcnt = nullptr; }
#pragma unroll
        for (int k = 0; k < RP; ++k) { const int row = row0 + k * ngw; if (row < rend) {
            const float* mod = (const float*)(p.ws + OFF_MOD) + cond_of(row) * 6144;
            f32x4 g[4], sh[4], sc[4];
#pragma unroll
            for (int j = 0; j < 4; ++j) { const int col = 4 * lane + 256 * j; g[j] = *(const f32x4*)(p.in[I_GMIXPRE] + col); sh[j] = *(const f32x4*)(mod + col); sc[j] = *(const f32x4*)(mod + 1024 + col); }
            float s = 0.f;
#pragma unroll
            for (int j = 0; j < 4; ++j) s += dot4(v[k][j]);
            const float rstd = rsqrtf(wave_sum(s) * (1.f / DM) + EPS);
#pragma unroll
            for (int j = 0; j < 4; ++j) {
                const int col = 4 * lane + 256 * j;
                const f32x4 h = (v[k][j] * rstd) * g[j] * (sc[j] + 1.f) + sh[j];
                u32x2 o; o.x = pk_bf16(h.x, h.y); o.y = pk_bf16(h.z, h.w);
                *(u32x2*)(H + (size_t)row * DM + col) = o;
            } } }
    }
}
template <int RP> DI void p5_rows(const P& p, const int gw, const int ngw, const int rend, const int lane, unsigned* waitcnt = nullptr, int tid = 0) {
    bf16_t* H = (bf16_t*)(p.ws + OFF_H); const bf16_t* MA = (const bf16_t*)(p.ws + OFF_MIX); const bf16_t* MB = MA + (size_t)NTOK * DM; const float* SS = (const float*)(p.ws + OFF_SS);
    for (int row0 = gw; row0 < rend; row0 += RP * ngw) {
        f32x4 xv[RP][4]; u32x2 ma[RP][4], mb[RP][4]; float sv[RP];
#pragma unroll
        for (int k = 0; k < RP; ++k) { const int row = row0 + k * ngw; if (row < rend) { const float* x = xrow_ptr(p, row);
            sv[k] = (lane < 16) ? SS[(size_t)row * 16 + lane] : 0.f;
#pragma unroll
            for (int j = 0; j < 4; ++j) { const int col = 4 * lane + 256 * j; xv[k][j] = __builtin_nontemporal_load((const f32x4*)(x + col)); } } }
        float rsa_[RP], rsb_[RP];
#pragma unroll
        for (int k = 0; k < RP; ++k) { rsa_[k] = 0.f; rsb_[k] = 0.f; const int row = row0 + k * ngw; if (row < rend) {
            float sa = (lane < 8) ? sv[k] : 0.f, sb = (lane >= 8) ? sv[k] : 0.f;
            sa = wave_sum(sa); sb = wave_sum(sb);
            rsa_[k] = rsqrtf(sa * (1.f / 512.f) + EPS); rsb_[k] = rsqrtf(sb * (1.f / 512.f) + EPS); } }
        if (waitcnt) { wait_count(waitcnt, 8u, tid); waitcnt = nullptr; }
#pragma unroll
        for (int k = 0; k < RP; ++k) { const int row = row0 + k * ngw; if (row < rend) {
#pragma unroll
            for (int j = 0; j < 4; ++j) { const int col = 4 * lane + 256 * j; ma[k][j] = __builtin_nontemporal_load((const u32x2*)(MA + (size_t)row * DM + col)); mb[k][j] = __builtin_nontemporal_load((const u32x2*)(MB + (size_t)row * DM + col)); } } }
#pragma unroll
        for (int k = 0; k < RP; ++k) { const int row = row0 + k * ngw; if (row < rend) {
            const float* mod = (const float*)(p.ws + OFF_MOD) + cond_of(row) * 6144;
            const float rsa = rsa_[k], rsb = rsb_[k];
            f32x4 mx[4]; float sm = 0.f;
#pragma unroll
            for (int j = 0; j < 4; ++j) {
                f32x4 a, b; a.x = __uint_as_float(ma[k][j].x << 16); a.y = __uint_as_float(ma[k][j].x & 0xffff0000u); a.z = __uint_as_float(ma[k][j].y << 16); a.w = __uint_as_float(ma[k][j].y & 0xffff0000u);
                b.x = __uint_as_float(mb[k][j].x << 16); b.y = __uint_as_float(mb[k][j].x & 0xffff0000u); b.z = __uint_as_float(mb[k][j].y << 16); b.w = __uint_as_float(mb[k][j].y & 0xffff0000u);
                mx[j] = a * rsa + b * rsb; sm += dot4(mx[j]); }
            const float rstd_m = rsqrtf(wave_sum(sm) * (1.f / DM) + EPS);
            float s = 0.f;
#pragma unroll
            for (int j = 0; j < 4; ++j) {
                const int col = 4 * lane + 256 * j;
                const f32x4 g = *(const f32x4*)(p.in[I_GMIXPOST] + col), gt = *(const f32x4*)(mod + 2048 + col);
                xv[k][j] = xv[k][j] + gt * ((mx[j] * rstd_m) * g);
                { u32x2 ox; ox.x = pk_bf16(xv[k][j].x, xv[k][j].y); ox.y = pk_bf16(xv[k][j].z, xv[k][j].w); *(u32x2*)((bf16_t*)(p.ws + OFF_Z) + (size_t)row * DM + col) = ox; }
                s += dot4(xv[k][j]);
            }
            const float rstd = rsqrtf(wave_sum(s) * (1.f / DM) + EPS);
#pragma unroll
            for (int j = 0; j < 4; ++j) {
                const int col = 4 * lane + 256 * j;
                const f32x4 g = *(const f32x4*)(p.in[I_GFFNPRE] + col), sh = *(const f32x4*)(mod + 3072 + col), sc = *(const f32x4*)(mod + 4096 + col);
                const f32x4 h = (xv[k][j] * rstd) * g * (sc + 1.f) + sh;
                u32x2 o; o.x = pk_bf16(h.x, h.y); o.y = pk_bf16(h.z, h.w);
                *(u32x2*)(H + (size_t)row * DM + col) = o;
            } } }
    }
}
template <int RP> DI void p8_rows(const P& p, const int gw, const int ngw, const int rend, const int lane, unsigned* waitcnt = nullptr, int tid = 0) {
    const bf16_t* F0 = (const bf16_t*)(p.ws + OFF_MIX); const bf16_t* F1 = F0 + (size_t)NTOK * DM;
    for (int row0 = gw; row0 < rend; row0 += RP * ngw) {
        f32x4 x1[RP][4]; u32x2 fa[RP][4], fb[RP][4];
#pragma unroll
        for (int k = 0; k < RP; ++k) { const int row = row0 + k * ngw; if (row < rend) {
#pragma unroll
            for (int j = 0; j < 4; ++j) { const int col = 4 * lane + 256 * j; x1[k][j] = ld_bf4((const bf16_t*)(p.ws + OFF_Z) + (size_t)row * DM + col); } } }
        if (waitcnt) { wait_count(waitcnt, 8u, tid); waitcnt = nullptr; }
#pragma unroll
        for (int k = 0; k < RP; ++k) { const int row = row0 + k * ngw; if (row < rend) {
#pragma unroll
            for (int j = 0; j < 4; ++j) { const int col = 4 * lane + 256 * j; fa[k][j] = __builtin_nontemporal_load((const u32x2*)(F0 + (size_t)row * DM + col)); fb[k][j] = __builtin_nontemporal_load((const u32x2*)(F1 + (size_t)row * DM + col)); } } }
#pragma unroll
        for (int k = 0; k < RP; ++k) { const int row = row0 + k * ngw; if (row < rend) {
            const float* mod = (const float*)(p.ws + OFF_MOD) + cond_of(row) * 6144;
            f32x4 fv[4]; float s = 0.f;
#pragma unroll
            for (int j = 0; j < 4; ++j) {
                f32x4 a, b; a.x = __uint_as_float(fa[k][j].x << 16); a.y = __uint_as_float(fa[k][j].x & 0xffff0000u); a.z = __uint_as_float(fa[k][j].y << 16); a.w = __uint_as_float(fa[k][j].y & 0xffff0000u);
                b.x = __uint_as_float(fb[k][j].x << 16); b.y = __uint_as_float(fb[k][j].x & 0xffff0000u); b.z = __uint_as_float(fb[k][j].y << 16); b.w = __uint_as_float(fb[k][j].y & 0xffff0000u);
                fv[j] = a + b; s += dot4(fv[j]); }
            const float rstd_f = rsqrtf(wave_sum(s) * (1.f / DM) + EPS);
#pragma unroll
            for (int j = 0; j < 4; ++j) {
                const int col = 4 * lane + 256 * j;
                const f32x4 g = *(const f32x4*)(p.in[I_GFFNPOST] + col), gt = *(const f32x4*)(mod + 5120 + col);
                __builtin_nontemporal_store(x1[k][j] + gt * ((fv[j] * rstd_f) * g), (f32x4*)(p.out + OUT_Y + (size_t)row * DM + col));
            } } }
    }
}

struct EpiInproj {
    static constexpr bool PERM = false, AFTER_DRAIN = false;
    bf16_t* Z; float* out;
    DI void operator()(const f32x4 (&acc)[2][2][4][2], const pg8::Unit& u, int wr, int wc, int fr, int fq) const {
        const bool sample = (u.pm >= 16);
        const int pn = u.pn;
        const bool isq = (pn < 2) || (pn == 6) || (pn == 7);
        float inv[4];
#pragma unroll
        for (int e = 0; e < 4; ++e) inv[e] = __builtin_amdgcn_exp2f(-(float)(fq * 4 + e) * (13.287712379549449f / 16.f)) * 0.15915494309189535f;
#pragma unroll
        for (int bj = 0; bj < 2; ++bj) {
            const bool rope = sample && (pn == 6 || pn == 7 || (pn == 8 && bj == 0));
            float* fo = nullptr; int fpitch = 0, fcol = 0;
            if (!sample) {
                if (pn == 2 || pn == 3) { fo = out + OUT_AK; fpitch = 512; fcol = (pn - 2) * 256 + bj * 128; }
                else if (pn == 4 || pn == 5) { fo = out + OUT_AV; fpitch = 512; fcol = (pn - 4) * 256 + bj * 128; }
                else if (pn == 8) { fo = out + (bj == 0 ? OUT_BK : OUT_BV); fpitch = 128; fcol = 0; }
            }
            const int zcol = pn * 256 + bj * 128 + wc * 32 + 4 * fq;
            const float qs = isq ? 0.18033688011112042f : 1.f;
#pragma unroll
            for (int ai = 0; ai < 2; ++ai)
#pragma unroll
                for (int m = 0; m < 4; ++m) {
                    const int grow = u.pm * 256 + ai * 128 + wr * 64 + m * 16 + fr;
                    f32x4 v0 = acc[ai][bj][m][0], v1 = acc[ai][bj][m][1];
                    if (fo) { float* fp = fo + (size_t)grow * fpitch + fcol + wc * 32 + 4 * fq; __builtin_nontemporal_store(v0, (f32x4*)fp); __builtin_nontemporal_store(v1, (f32x4*)(fp + 16)); }
                    if (rope) {
                        const int pos = (grow - NPROMPT) & 1023; const float ps = (wc & 1) ? (float)(pos & 63) : (float)(pos >> 6);
#pragma unroll
                        for (int e = 0; e < 4; ++e) {
                            float a = ps * inv[e]; a -= floorf(a);
                            const float cs = __builtin_amdgcn_cosf(a), sn = __builtin_amdgcn_sinf(a);
                            const float x1 = v0[e], x2 = v1[e];
                            v0[e] = x1 * cs - x2 * sn; v1[e] = x2 * cs + x1 * sn;
                        }
                    }
                    v0 *= qs; v1 *= qs;
                    bf16_t* zp = Z + (size_t)grow * INW + zcol;
                    u32x2 o0, o1; o0.x = pk_bf16(v0.x, v0.y); o0.y = pk_bf16(v0.z, v0.w); o1.x = pk_bf16(v1.x, v1.y); o1.y = pk_bf16(v1.z, v1.w);
                    { auto rx = __builtin_amdgcn_permlane16_swap(o0.x, o1.x, false, false); auto ry = __builtin_amdgcn_permlane16_swap(o0.y, o1.y, false, false);
                      u32x4 o4; o4.x = rx[0]; o4.y = ry[0]; o4.z = rx[1]; o4.w = ry[1];
                      *(u32x4*)(zp + ((fq & 1) ? 12 : 0)) = o4; }
                }
        }
    }
};
DI void st16_wt(void* ptr, u32x4 v) { asm volatile("global_store_dwordx4 %0, %1, off sc1\n\ts_nop 1" :: "v"(ptr), "v"(v) : "memory"); }
struct EpiF32 {
    static constexpr bool PERM = true, AFTER_DRAIN = false;
    bf16_t* O;
    DI void operator()(const f32x4 (&acc)[2][2][4][2], const pg8::Unit& u, int wr, int wc, int fr, int fq) const {
        bf16_t* base = O + (size_t)(u.pn >> 2) * NTOK * DM + (u.pn & 3) * 256 + wc * 32 + 8 * fq;
#pragma unroll
        for (int ai = 0; ai < 2; ++ai)
#pragma unroll
            for (int m = 0; m < 4; ++m) {
                bf16_t* rp = base + (size_t)(u.pm * 256 + ai * 128 + wr * 64 + m * 16 + fr) * DM;
#pragma unroll
                for (int bj = 0; bj < 2; ++bj) {
                    const f32x4 v0 = acc[ai][bj][m][0], v1 = acc[ai][bj][m][1];
                    u32x4 o; o.x = pk_bf16(v0.x, v0.y); o.y = pk_bf16(v0.z, v0.w); o.z = pk_bf16(v1.x, v1.y); o.w = pk_bf16(v1.z, v1.w);
                    st16_wt(rp + bj * 128, o);
                }
            }
    }
};
DI float dpp_prev(float x) { int u_; asm("" : "=v"(u_)); return __builtin_bit_cast(float, __builtin_amdgcn_update_dpp(u_, __builtin_bit_cast(int, x), 0x121, 0xf, 0xf, true)); }
DI float dpp_next(float x) { int u_; asm("" : "=v"(u_)); return __builtin_bit_cast(float, __builtin_amdgcn_update_dpp(u_, __builtin_bit_cast(int, x), 0x12f, 0xf, 0xf, true)); }
template <bool WT> struct EpiUp {
    static constexpr bool PERM = WT, AFTER_DRAIN = false;
    bf16_t* ACT; const float* cw; const float* cb;
    DI void operator()(const f32x4 (&acc)[2][2][4][2], const pg8::Unit& u, int wr, int wc, int fr, int fq) const {
#pragma unroll
        for (int ai = 0; ai < 2; ++ai) {
            const int tok0 = 62 * (u.pm * 4 + ai * 2 + wr) - 1;
            u32x2 keep[4];
#pragma unroll
            for (int n = 0; n < 2; ++n) {
                const int j = WT ? u.pn * 128 + wc * 32 + 8 * fq + 4 * n : u.pn * 128 + wc * 32 + 16 * n + 4 * fq;
                const f32x4 wg0 = *(const f32x4*)(cw + j), wg1 = *(const f32x4*)(cw + UPW + j), wg2 = *(const f32x4*)(cw + 2 * UPW + j), bg = *(const f32x4*)(cb + j);
                const f32x4 wv0 = *(const f32x4*)(cw + DFF + j), wv1 = *(const f32x4*)(cw + UPW + DFF + j), wv2 = *(const f32x4*)(cw + 2 * UPW + DFF + j), bv = *(const f32x4*)(cb + DFF + j);
#pragma unroll
                for (int m = 0; m < 4; ++m) {
                    const int local = m * 16 + fr, token = tok0 + local;
                    const f32x4 gc = acc[ai][0][m][n], vc = acc[ai][1][m][n];
                    const f32x4 gpa = acc[ai][0][m > 0 ? m - 1 : 0][n], vpa = acc[ai][1][m > 0 ? m - 1 : 0][n];
                    const f32x4 gna = acc[ai][0][m < 3 ? m + 1 : 3][n], vna = acc[ai][1][m < 3 ? m + 1 : 3][n];
                    f32x4 gp, gn, vp, vn;
#pragma unroll
                    for (int e = 0; e < 4; ++e) {
                        gp[e] = dpp_prev(fr == 15 ? gpa[e] : gc[e]); gn[e] = dpp_next(fr == 0 ? gna[e] : gc[e]);
                        vp[e] = dpp_prev(fr == 15 ? vpa[e] : vc[e]); vn[e] = dpp_next(fr == 0 ? vna[e] : vc[e]);
                    }
                    const int pos = token < NPROMPT ? (token & 255) : ((token - NPROMPT) & 1023), L = token < NPROMPT ? 256 : 1024;
                    const float mp = pos > 0 ? 1.f : 0.f, mn = pos < L - 1 ? 1.f : 0.f;
                    f32x4 g, v;
                    if (__builtin_amdgcn_ballot_w64(mp == 0.f || mn == 0.f) == 0ull) {
                        g = gp * wg0 + gc * wg1 + gn * wg2 + bg; v = vp * wv0 + vc * wv1 + vn * wv2 + bv;
                    } else {
                        g = (gp * mp) * wg0 + gc * wg1 + (gn * mn) * wg2 + bg; v = (vp * mp) * wv0 + vc * wv1 + (vn * mn) * wv2 + bv;
                    }
                    f32x4 a;
#pragma unroll
                    for (int e = 0; e < 4; ++e) a[e] = silu_f(g[e]) * v[e];
                    u32x2 o; o.x = pk_bf16(a.x, a.y); o.y = pk_bf16(a.z, a.w);
                    if (WT) {
                        if (n == 0) keep[m] = o;
                        else if (local >= 1 && local <= 62 && token < NTOK) { u32x4 o4; o4.x = keep[m].x; o4.y = keep[m].y; o4.z = o.x; o4.w = o.y; st16_wt(ACT + (size_t)token * DFF + (j - 4), o4); }
                    } else {
                        if ((m & 1) == 0) keep[m] = o;
                        else {
                            auto rx = __builtin_amdgcn_permlane16_swap(keep[m - 1].x, o.x, false, false); auto ry = __builtin_amdgcn_permlane16_swap(keep[m - 1].y, o.y, false, false);
                            u32x4 o4; o4.x = rx[0]; o4.y = ry[0]; o4.z = rx[1]; o4.w = ry[1];
                            const bool oddq = (fq & 1) != 0; const int loc = oddq ? local : local - 16, tok = tok0 + loc;
                            if (loc >= 1 && loc <= 62 && tok < NTOK) *(u32x4*)(ACT + (size_t)tok * DFF + (oddq ? j - 4 : j)) = o4;
                        }
                    }
                }
            }
        }
    }
};

DI void tr_read8(unsigned a0, unsigned a1, unsigned a2, unsigned a3, unsigned a4, unsigned a5, unsigned a6, unsigned a7,
                 s16x4& r0, s16x4& r1, s16x4& r2, s16x4& r3, s16x4& r4, s16x4& r5, s16x4& r6, s16x4& r7) {
    asm volatile("ds_read_b64_tr_b16 %0, %8\n\tds_read_b64_tr_b16 %1, %9\n\tds_read_b64_tr_b16 %2, %10\n\tds_read_b64_tr_b16 %3, %11\n\t"
                 "ds_read_b64_tr_b16 %4, %12\n\tds_read_b64_tr_b16 %5, %13\n\tds_read_b64_tr_b16 %6, %14\n\tds_read_b64_tr_b16 %7, %15\n\ts_waitcnt lgkmcnt(0)"
                 : "=&v"(r0), "=&v"(r1), "=&v"(r2), "=&v"(r3), "=&v"(r4), "=&v"(r5), "=&v"(r6), "=&v"(r7)
                 : "v"(a0), "v"(a1), "v"(a2), "v"(a3), "v"(a4), "v"(a5), "v"(a6), "v"(a7) : "memory");
}
typedef short v4i16_t __attribute__((ext_vector_type(4)));
DI s16x4 vtr(LAS const unsigned char* p) { return __builtin_bit_cast(s16x4, __builtin_amdgcn_ds_read_tr16_b64_v4i16((LAS v4i16_t*)p)); }
DI float quad_max(float v) {
    auto a = __builtin_amdgcn_permlane16_swap(__float_as_uint(v), __float_as_uint(v), false, false);
    const float t = fmaxf(__uint_as_float(a[0]), __uint_as_float(a[1]));
    auto b = __builtin_amdgcn_permlane32_swap(__float_as_uint(t), __float_as_uint(t), false, false);
    return fmaxf(__uint_as_float(b[0]), __uint_as_float(b[1]));
}
DI float quad_sum(float v) {
    auto a = __builtin_amdgcn_permlane16_swap(__float_as_uint(v), __float_as_uint(v), false, false);
    const float t = __uint_as_float(a[0]) + __uint_as_float(a[1]);
    auto b = __builtin_amdgcn_permlane32_swap(__float_as_uint(t), __float_as_uint(t), false, false);
    return __uint_as_float(b[0]) + __uint_as_float(b[1]);
}
struct AttState { f32x4 o[4]; float m, l; };
struct AttUnit { int tq0, qcol, ktok0, kcol, vcol, nt0, nt1, ocol, slot, kstart, rs0, qb, cpitch; const bf16_t* ck; const bf16_t* cv; float m0, l0; };
template <int MODE>
DI void att_tile(AttState& st, const bf16_t* Kt, const LAS unsigned char* Vt3, const bf16x8 (&qf)[2], const int lr, const int quad, const int dq, const int ws, const float* bt, const int (&bidx)[2][4]) {
    constexpr int NKT = (MODE == 2) ? 2 : 4;
    const int koff = (MODE == 2) ? ws : 0;
    f32x4 s[NKT];
    bf16x8 kf[NKT][2];
#pragma unroll
    for (int kt = 0; kt < NKT; ++kt)
#pragma unroll
        for (int ks = 0; ks < 2; ++ks) kf[kt][ks] = *(const bf16x8*)(Kt + (koff + kt * 16 + lr) * LDP + ks * 32 + quad * 8);
    __builtin_amdgcn_s_setprio(1);
#pragma unroll
    for (int kt = 0; kt < NKT; ++kt) {
        s[kt] = __builtin_amdgcn_mfma_f32_16x16x32_bf16(kf[kt][0], qf[0], (f32x4){0.f, 0.f, 0.f, 0.f}, 0, 0, 0);
        s[kt] = __builtin_amdgcn_mfma_f32_16x16x32_bf16(kf[kt][1], qf[1], s[kt], 0, 0, 0);
    }
    __builtin_amdgcn_s_setprio(0);
    const LAS unsigned char* vrow = Vt3 + (unsigned)(((koff + quad * 4 + (lr >> 2)) * LDP + 4 * (lr & 3)) * 2);
    s16x4 vlo[NKT / 2][4], vhi[NKT / 2][4];
#pragma unroll
    for (int s2 = 0; s2 < NKT / 2; ++s2)
#pragma unroll
        for (int d = 0; d < 4; ++d) { vlo[s2][d] = vtr(vrow + s2 * 32 * LDP * 2 + d * 32); vhi[s2][d] = vtr(vrow + (s2 * 32 + 16) * LDP * 2 + d * 32); }
    if (MODE == 1) {
#pragma unroll
        for (int kt = 0; kt < NKT; ++kt)
#pragma unroll
            for (int e = 0; e < 4; ++e) { int dd = dq - (kt * 16 + quad * 4 + e); dd = dd < 0 ? -dd : dd; s[kt][e] = (dd <= 128) ? s[kt][e] : -INFINITY; }
    }
    if (MODE == 2) {
#pragma unroll
        for (int kt = 0; kt < NKT; ++kt)
#pragma unroll
            for (int e = 0; e < 4; ++e) s[kt][e] += bt[bidx[kt][e]];
    }
    float mx = fmaxf(fmaxf(fmaxf(s[0][0], s[0][1]), fmaxf(s[0][2], s[0][3])), fmaxf(fmaxf(s[1][0], s[1][1]), fmaxf(s[1][2], s[1][3])));
    if (NKT == 4) mx = fmaxf(mx, fmaxf(fmaxf(fmaxf(s[NKT - 2][0], s[NKT - 2][1]), fmaxf(s[NKT - 2][2], s[NKT - 2][3])), fmaxf(fmaxf(s[NKT - 1][0], s[NKT - 1][1]), fmaxf(s[NKT - 1][2], s[NKT - 1][3]))));
    mx = quad_max(mx);
    const float m_new = fmaxf(st.m, mx);
    if (__builtin_amdgcn_ballot_w64(m_new > st.m) != 0ull) {
        const float alpha = __builtin_amdgcn_exp2f(st.m - m_new);
        st.l *= alpha;
        const f32x2 a2 = {alpha, alpha};
#pragma unroll
        for (int d = 0; d < 4; ++d) { f32x2 lo = {st.o[d][0], st.o[d][1]}, hi = {st.o[d][2], st.o[d][3]}; lo *= a2; hi *= a2; st.o[d] = (f32x4){lo.x, lo.y, hi.x, hi.y}; }
        st.m = m_new;
    }
    const f32x2 mm = {m_new, m_new};
    f32x2 ps2 = {0.f, 0.f};
#pragma unroll
    for (int kt = 0; kt < NKT; ++kt) {
        f32x2 lo = {s[kt][0], s[kt][1]}, hi = {s[kt][2], s[kt][3]}; lo -= mm; hi -= mm;
        s[kt][0] = __builtin_amdgcn_exp2f(lo.x); s[kt][1] = __builtin_amdgcn_exp2f(lo.y); s[kt][2] = __builtin_amdgcn_exp2f(hi.x); s[kt][3] = __builtin_amdgcn_exp2f(hi.y);
        ps2 += (f32x2){s[kt][0], s[kt][1]}; ps2 += (f32x2){s[kt][2], s[kt][3]};
    }
    st.l += ps2.x + ps2.y;
#pragma unroll
    for (int s2 = 0; s2 < NKT / 2; ++s2) {
        u32x4 pbu; pbu.x = pk_bf16(s[2 * s2][0], s[2 * s2][1]); pbu.y = pk_bf16(s[2 * s2][2], s[2 * s2][3]); pbu.z = pk_bf16(s[2 * s2 + 1][0], s[2 * s2 + 1][1]); pbu.w = pk_bf16(s[2 * s2 + 1][2], s[2 * s2 + 1][3]);
        const bf16x8 pb = __builtin_bit_cast(bf16x8, pbu);
        __builtin_amdgcn_s_setprio(1);
#pragma unroll
        for (int d = 0; d < 4; ++d) st.o[d] = __builtin_amdgcn_mfma_f32_16x16x32_bf16(__builtin_shufflevector(vlo[s2][d], vhi[s2][d], 0, 1, 2, 3, 4, 5, 6, 7), pb, st.o[d], 0, 0, 0);
        __builtin_amdgcn_s_setprio(0);
    }
}
template <int TYPE>
DI void attn_unit(const P& p, const AttUnit& au, unsigned char* lds, const int tid, const bool reuse_kv = false) {
    bf16_t* Kl = (bf16_t*)lds; bf16_t* Vl = Kl + 256 * LDP; float* rpbl = (float*)(lds + 2 * 256 * LDP * 2);
    const LAS unsigned char* Vl3 = (const LAS unsigned char*)lds + 256 * LDP * 2;
    const int w = tid >> 6, lane = tid & 63, lr = lane & 15, quad = lane >> 4;
    const bf16_t* Z = (const bf16_t*)(p.ws + OFF_Z);
    const int total = au.nt0 + au.nt1, nchunks = (total + 3) >> 2;
    const int qidx = w * 16 + lr;
    if (!reuse_kv) __syncthreads();
    int bidx[2][4] = {{0, 0, 0, 0}, {0, 0, 0, 0}}; int ws = 0, rsg = 0;
    if (TYPE == 2) {
        const int hh = au.ocol >> 6;
        if (tid < 480) { const int dr = tid >> 5, c = tid & 31; rpbl[tid] = c < 31 ? p.in[I_RPB][hh * 465 + dr * 31 + c] * 1.4426950408889634f : -INFINITY; }
        const int wq = w & 3; ws = wq == 0 ? 0 : (wq == 1 ? 8 : (wq == 2 ? 24 : 32));
        const int qc = qidx & 63; int cs = qc - 8; cs = cs < 0 ? 0 : (cs > 48 ? 48 : cs);
#pragma unroll
        for (int kt = 0; kt < 2; ++kt)
#pragma unroll
            for (int e = 0; e < 4; ++e) { const int kc = ws + kt * 16 + quad * 4 + e; int dc = kc - qc; dc = dc < -15 ? -15 : (dc > 15 ? 15 : dc); bidx[kt][e] = ((kc >= cs) && (kc < cs + 16)) ? dc + 15 : 31; }
        rsg = 2 * au.qb + (w >> 2) - 4; rsg = rsg < 0 ? 0 : (rsg > 8 ? 8 : rsg);
    }
    bf16x8 qf[2];
    {
        const bf16_t* qp = Z + (size_t)(au.tq0 + qidx) * INW + au.qcol + quad * 8;
        qf[0] = *(const bf16x8*)qp; qf[1] = *(const bf16x8*)(qp + 32);
    }
    AttState st;
#pragma unroll
    for (int d = 0; d < 4; ++d) st.o[d] = (f32x4){0.f, 0.f, 0.f, 0.f};
    st.m = au.m0; st.l = (quad == 0) ? au.l0 : 0.f;
    u32x4 rk[4], rv[4];
#define ATT_PREFETCH(c) do { _Pragma("unroll") for (int i_ = 0; i_ < 4; ++i_) { const int pc_ = tid + NTHR * i_, row_ = pc_ >> 3, c16_ = (pc_ & 7) * 8; const int ti_ = 4 * (c) + (row_ >> 6); \
        if (ti_ < total) { const bf16_t *kp_, *vp_; \
            if (ti_ < au.nt0) { const size_t ro_ = (size_t)(au.ktok0 + ti_ * 64 + (row_ & 63)) * INW + c16_; kp_ = Z + ro_ + au.kcol; vp_ = Z + ro_ + au.vcol; } \
            else { const size_t ro_ = (size_t)((ti_ - au.nt0) * 64 + (row_ & 63)) * au.cpitch + c16_; kp_ = au.ck + ro_; vp_ = au.cv + ro_; } \
            rk[i_] = *(const u32x4*)kp_; rv[i_] = *(const u32x4*)vp_; } } } while (0)
    if (!reuse_kv) ATT_PREFETCH(0);
    for (int c = 0; c < nchunks; ++c) {
        if (!(reuse_kv && c == 0)) {
        if (c > 0) __syncthreads();
#pragma unroll
        for (int i = 0; i < 4; ++i) { const int pc = tid + NTHR * i, lo_ = (pc >> 3) * LDP + (pc & 7) * 8; *(u32x4*)(Kl + lo_) = rk[i]; *(u32x4*)(Vl + lo_) = rv[i]; }
        __syncthreads();
        }
        if (c + 1 < nchunks) ATT_PREFETCH(c + 1);
        for (int tt = 0; tt < 4; ++tt) {
            const int t = 4 * c + tt;
            if (t >= total) break;
            const bf16_t* Kt = Kl + tt * 64 * LDP; const LAS unsigned char* Vt3 = Vl3 + tt * 64 * LDP * 2;
            if (TYPE == 2 && t < au.nt0) {
                const int kr = au.rs0 + t; if (kr < rsg || kr >= rsg + 8) continue;
                const int drow = kr - (2 * au.qb + (w >> 2)) + 7;
                att_tile<2>(st, Kt, Vt3, qf, lr, quad, 0, ws, rpbl + drow * 32, bidx);
            } else if (TYPE == 3 && t < au.nt0) {
                const int qw = au.qb * 128 + w * 16, k0 = au.kstart + t * 64;
                if (k0 + 63 < qw - 128 || k0 > qw + 15 + 128) continue;
                if (k0 < qw + 15 - 128 || k0 + 63 > qw + 128) att_tile<1>(st, Kt, Vt3, qf, lr, quad, au.qb * 128 + qidx - k0, 0, nullptr, bidx);
                else att_tile<0>(st, Kt, Vt3, qf, lr, quad, 0, 0, nullptr, bidx);
            } else att_tile<0>(st, Kt, Vt3, qf, lr, quad, 0, 0, nullptr, bidx);
        }
    }
#undef ATT_PREFETCH
    bf16_t* O = (bf16_t*)(p.ws + OFF_O); float* SS = (float*)(p.ws + OFF_SS);
    const float il = 1.f / quad_sum(st.l);
    const int tok = au.tq0 + qidx;
    float ss = 0.f;
#pragma unroll
    for (int d = 0; d < 4; ++d) {
        const f32x4 v = st.o[d] * il; ss += dot4(v);
        u32x2 ov; ov.x = pk_bf16(v.x, v.y); ov.y = pk_bf16(v.z, v.w);
        *(u32x2*)(O + (size_t)tok * DM + au.ocol + d * 16 + quad * 4) = ov;
    }
    ss = quad_sum(ss);
    if (quad == 0) SS[(size_t)tok * 16 + au.slot] = ss;
}
DI void attn_phase(const P& p, int bid, int nb, unsigned char* lds, int tid) {
    for (int u = bid; u < 768; u += nb) {
        int type, b, h, qb;
        if (u < 128) { type = 2; b = u >> 6; h = (u >> 3) & 7; qb = u & 7; }
        else if (u < 256) { type = 3; const int v = u - 128; b = v >> 6; h = (v >> 3) & 7; qb = v & 7; }
        else { const int pr = (u - 256) & 255; qb = (u - 256) >> 8; type = pr >> 7; b = (pr >> 3) & 15; h = pr & 7; }
        const bool reuse = (nb == 256) && (u >= 512);
        AttUnit au; au.qb = qb; au.nt1 = 0; au.kstart = 0; au.rs0 = 0; au.ck = nullptr; au.cv = nullptr; au.cpitch = 0; au.m0 = -1e30f; au.l0 = 0.f;
        if (type == 0) { au.tq0 = b * 256 + qb * 128; au.qcol = h * 64; au.ktok0 = b * 256; au.kcol = 512 + h * 64; au.vcol = 1024 + h * 64; au.nt0 = 4; au.ocol = h * 64; au.slot = h; attn_unit<0>(p, au, lds, tid, reuse); }
        else if (type == 1) { au.tq0 = b * 256 + qb * 128; au.qcol = 1536 + h * 64; au.ktok0 = b * 256; au.kcol = 2048 + (h >> 2) * 64; au.vcol = 2176 + (h >> 2) * 64; au.nt0 = 4; au.ocol = 512 + h * 64; au.slot = 8 + h;
            au.m0 = p.in[I_SINK][h] * 1.4426950408889634f; au.l0 = 1.f; attn_unit<1>(p, au, lds, tid, reuse); }
        else if (type == 2) { au.tq0 = NPROMPT + b * 1024 + qb * 128; au.qcol = h * 64;
            int rs0 = 2 * qb - 4; rs0 = rs0 < 0 ? 0 : (rs0 > 8 ? 8 : rs0); int rs1 = 2 * qb + 1 - 4; rs1 = rs1 < 0 ? 0 : (rs1 > 8 ? 8 : rs1); au.rs0 = rs0;
            au.ktok0 = NPROMPT + b * 1024 + rs0 * 64; au.kcol = 512 + h * 64; au.vcol = 1024 + h * 64; au.nt0 = rs1 + 8 - rs0; au.ocol = h * 64; au.slot = h;
            au.nt1 = 4; au.ck = (const bf16_t*)(p.ws + OFF_CAK) + (size_t)b * 256 * 512 + h * 64; au.cv = (const bf16_t*)(p.ws + OFF_CAV) + (size_t)b * 256 * 512 + h * 64; au.cpitch = 512; attn_unit<2>(p, au, lds, tid); }
        else { au.tq0 = NPROMPT + b * 1024 + qb * 128; au.qcol = 1536 + h * 64; int kstart = qb * 128 - 128; if (kstart < 0) kstart = 0; int kend = qb * 128 + 256; if (kend > 1024) kend = 1024; au.kstart = kstart;
            au.ktok0 = NPROMPT + b * 1024 + kstart; au.kcol = 2048 + (h >> 2) * 64; au.vcol = 2176 + (h >> 2) * 64; au.nt0 = (kend - kstart) >> 6; au.ocol = 512 + h * 64; au.slot = 8 + h;
            au.nt1 = 4; au.ck = (const bf16_t*)(p.ws + OFF_CBK) + (size_t)b * 256 * 128 + (h >> 2) * 64; au.cv = (const bf16_t*)(p.ws + OFF_CBV) + (size_t)b * 256 * 128 + (h >> 2) * 64; au.cpitch = 128;
            au.m0 = p.in[I_SINK][h] * 1.4426950408889634f; au.l0 = 1.f; attn_unit<3>(p, au, lds, tid); }
    }
}

struct UpOrder {
    int c, tail;
    DI bool next(int i, pg8::Unit& u) const {
        if (tail) { if (i > 0 || c >= 38) return false; u.pm = c >> 1; u.pn = (c & 1) ? 21 : 10; return true; }
        if (i >= 2) return false;
        const int s = i * 256 + (c & 7) * 32 + (c >> 3);
        if (s < 500) { const int g = s / 160, w = s % 160, gsz = (g < 3) ? 8 : 1; u.pm = 8 * g + (w % gsz); const int pi = w / gsz; u.pn = pi < 10 ? pi : pi + 1; }
        else { const int e = s - 500; u.pm = 19 + (e >> 1); u.pn = (e & 1) ? 21 : 10; }
        return true;
    }
    DI void a_ready(const pg8::Unit&) const {}
    DI void done(const pg8::Unit&) const {}
};
constexpr int CNT_BASE = 4096;
__global__ void __launch_bounds__(NTHR, 2) mega(P p) {
    extern __shared__ __attribute__((aligned(16))) unsigned char lds[];
    const int tid = threadIdx.x, bid = blockIdx.x, nb = gridDim.x, lane = tid & 63, wv = tid >> 6;
    volatile LAS unsigned* bst = (volatile LAS unsigned*)((LAS unsigned char*)lds + LDS_MAIN);
    if (tid < 16) bst[tid] = 0u;
    __syncthreads();
    unsigned* ctl = (unsigned*)(p.ws + OFF_BAR);
    XcdBarrier bar = xcd_barrier_post(ctl, bst);
    unsigned* cntA = ctl + CNT_BASE;
    unsigned* cnt4 = ctl + CNT_BASE + 64;
    unsigned* cnt7 = ctl + CNT_BASE + 64 + 24 * 64;
    LAS unsigned char* lds3 = (LAS unsigned char*)lds;
    float* scr = (float*)lds;
    bf16_t* wsH = (bf16_t*)(p.ws + OFF_H);
    const bool std_grid = (nb == 256);
    p0_phase(p, bid, nb, scr, tid, cntA);
    p1_rows<3>(p, bid * NWAVE + wv, nb * NWAVE, NTOK, lane, cntA, tid);
    xcd_barrier(bar);
    {
        pg8::Gemm g{wsH, (const bf16_t*)(p.ws + OFF_WIN), 1024, 1024, 1 << 30, 0, 0, nullptr, 0}; pg8::StaticOrder S; S.init(NTOK, INW, nb, bid);
        EpiInproj E{(bf16_t*)(p.ws + OFF_Z), p.out};
        pg8::gemm_phase<EpiInproj, pg8::StaticOrder, true, true>(lds3, g, S, E);
        __syncthreads();
        const int h0 = std_grid ? 216 : 0, nh = nb - h0;
        if (bid >= h0) tr_range(p, T_IN + (bid - h0), T_IN + T_OUT + 200, nh, scr, tid);
    }
    xcd_barrier(bar);
    attn_phase(p, bid, nb, lds, tid);
    xcd_barrier(bar);
    {
        pg8::Gemm g{(const bf16_t*)(p.ws + OFF_O), (const bf16_t*)(p.ws + OFF_WOUT), 512, 1024, 4, 1024, 0, nullptr, 0}; pg8::StaticOrder S; S.init(NTOK, 2048, nb, bid);
        EpiF32 E{(bf16_t*)(p.ws + OFF_MIX)};
        pg8::gemm_phase<EpiF32, pg8::StaticOrder, true, true>(lds3, g, S, E);
        __syncthreads();
        const int h0 = std_grid ? 192 : 0, nh = nb - h0;
        if (bid >= h0) tr_range(p, T_IN + T_OUT + 200 + (bid - h0), T_IN + T_OUT + T_UP + T_DOWN, nh, scr, tid);
        pg8::Unit u;
        if (nb >= 192) {
            if (S.next(0, u)) { publish_inc_wt(cnt4 + 64 * u.pm, tid); const int r0 = u.pm * 256 + u.pn * 32; p5_rows<4>(p, r0 + wv, NWAVE, r0 + 32, lane, cnt4 + 64 * u.pm, tid); }
        } else { xcd_barrier(bar); p5_rows<3>(p, bid * NWAVE + wv, nb * NWAVE, NTOK, lane); }
    }
    xcd_barrier(bar);
    unsigned* tflag = ctl + CNT_BASE + 64 + 48 * 64;
    {
        pg8::Gemm g{wsH, (const bf16_t*)(p.ws + OFF_WUP), 1024, 1024, 1 << 30, 0, 1, nullptr, 0}; UpOrder S{bid, 0};
        EpiUp<false> E{(bf16_t*)(p.ws + OFF_ACT), p.in[I_CONVW], p.in[I_CONVB]};
        pg8::gemm_phase<EpiUp<false>, UpOrder, true, true>(lds3, g, S, E);
    }
    xcd_barrier(bar);
    if (bid < 38) {
        pg8::Gemm g{wsH, (const bf16_t*)(p.ws + OFF_WUP), 1024, 1024, 1 << 30, 0, 1, nullptr, 0}; UpOrder S{bid, 1};
        EpiUp<true> E{(bf16_t*)(p.ws + OFF_ACT), p.in[I_CONVW], p.in[I_CONVB]};
        pg8::gemm_phase<EpiUp<true>, UpOrder, true, true>(lds3, g, S, E);
        publish_inc_wt(tflag + ((bid >> 1) * 2 + (bid & 1)) * 64, tid);
    } else {
        pg8::Gemm g{(const bf16_t*)(p.ws + OFF_ACT), (const bf16_t*)(p.ws + OFF_WDOWN), 1408, 2816, 4, 2816, 0, tflag, 18}; pg8::StaticOrder S; S.init(NTOK, 2048, nb, bid - 38);
        EpiF32 E{(bf16_t*)(p.ws + OFF_MIX)};
        pg8::gemm_phase<EpiF32, pg8::StaticOrder, true, true>(lds3, g, S, E);
        pg8::Unit u;
        if (S.next(0, u)) { publish_inc_wt(cnt7 + 64 * u.pm, tid); const int r0 = u.pm * 256 + u.pn * 32; p8_rows<4>(p, r0 + wv, NWAVE, r0 + 32, lane, cnt7 + 64 * u.pm, tid); }
    }
}

extern "C" void kernel_launch(void* const* d_in, const int* in_sizes, int n_in, void* d_out, int out_size, void* d_ws, size_t ws_size, hipStream_t stream) {
    static int grid_blocks = 0;
    if (!grid_blocks) {
        int dev = 0, cus = 0, per_cu = 0;
        (void)hipGetDevice(&dev);
        (void)hipDeviceGetAttribute(&cus, hipDeviceAttributeMultiprocessorCount, dev);
        (void)hipFuncSetAttribute((const void*)mega, hipFuncAttributeMaxDynamicSharedMemorySize, LDS_BYTES);
        (void)hipOccupancyMaxActiveBlocksPerMultiprocessor(&per_cu, (const void*)mega, NTHR, LDS_BYTES);
        if (per_cu < 1) { fprintf(stderr, "kernel_launch: occupancy query reports %d blocks per CU\n", per_cu); per_cu = 1; }
        grid_blocks = cus;
        if (cus != 256) fprintf(stderr, "kernel_launch: this kernel's unit orders are built for 256 CUs (MI355X); found %d\n", cus);
        if (n_in != 24 || ws_size < WS_END) fprintf(stderr, "kernel_launch: unexpected n_in %d / ws_size %zu (need %zu)\n", n_in, ws_size, (size_t)WS_END);
    }
    P p{};
    for (int i = 0; i < 24; ++i) p.in[i] = (const float*)d_in[i];
    p.out = (float*)d_out; p.ws = (unsigned char*)d_ws;
    (void)hipMemsetAsync((unsigned char*)d_ws + OFF_BAR, 0, 65536, stream);
    void* args[] = {&p};
    hipError_t e = hipLaunchCooperativeKernel((const void*)mega, dim3(grid_blocks), dim3(NTHR), args, LDS_BYTES, stream);
    if (e != hipSuccess) fprintf(stderr, "cooperative launch failed: %s (grid %d)\n", hipGetErrorString(e), grid_blocks);
}
```

```cpp
#include <hip/hip_runtime.h>
#include <hip/hip_cooperative_groups.h>
#include <cstdio>
#include <cstdint>
namespace cg = cooperative_groups;


namespace pg8 {
#define PG8_LAS __attribute__((address_space(3)))
typedef unsigned short bf16_t;
typedef short bf16x8 __attribute__((ext_vector_type(8)));
typedef float f32x4 __attribute__((ext_vector_type(4)));
typedef unsigned u32x4 __attribute__((ext_vector_type(4)));
constexpr int BM = 256, BK = 64, HALF = 128, HTB = HALF * BK * 2  , STAGE_BYTES = 8 * HTB, NXCD = 8, WGM = 8;

__host__ __device__ __forceinline__ int lds_byte(int r, int c) { const int st = (r >> 4) * 2 + (c >> 5), rr = r & 15, cc = c & 31, ob = rr * 64 + cc * 2; return st * 1024 + (ob ^ (((ob >> 9) & 1) << 5)); }
__host__ __device__ __forceinline__ void stage_rc(int b, int& R, int& C) { const int st = b / 1024, sb = b % 1024, swz = sb ^ (((sb >> 9) & 1) << 5); R = (st >> 1) * 16 + swz / 64; C = (st & 1) * 32 + (swz % 64) / 2; }
__host__ __device__ __forceinline__ int perm32(int rho) { const int n = rho >> 4, i = rho & 15; return 8 * (i >> 2) + 4 * n + (i & 3); }

struct Unit { int pm, pn; };
struct Gemm { const bf16_t* A; const bf16_t* Bt; int K, lda, nsplit, a_coloff, seg; const unsigned* kflags; int kwait_t; };

struct StaticOrder {
    int nM, nN, nwg, G, c;
    __host__ __device__ void init(int M, int N, int G_, int c_) { nM = M / BM; nN = N / BM; nwg = nM * nN; G = G_; c = c_; }
    __host__ __device__ bool next(int i, Unit& u) const {
        const long L = (long)i * G + c; if (L >= nwg) return false;
        int wgid = (int)L; { const int q = nwg / NXCD, r = nwg % NXCD, xcd = wgid % NXCD, off = wgid / NXCD; wgid = (xcd < r ? xcd * (q + 1) : r * (q + 1) + (xcd - r) * q) + off; }
        const int nig = WGM * nN, gid = wgid / nig, fm = gid * WGM, gsz = (nM - fm) < WGM ? (nM - fm) : WGM;
        u.pm = fm + ((wgid % nig) % gsz); u.pn = (wgid % nig) / gsz; return true;
    }
    __device__ __forceinline__ void a_ready(const Unit&) const {}
    __device__ __forceinline__ void done(const Unit&) const {}
};

template <class Epi, class Sched, bool ALIGN_EPI = false, bool SP2 = false>
__device__ __forceinline__ void gemm_phase(PG8_LAS unsigned char* lds, const Gemm g, const Sched& S, const Epi& E) {
    int tid_ = threadIdx.x; asm volatile("" : "+v"(tid_));
    const int tid = tid_, wid = __builtin_amdgcn_readfirstlane(tid >> 6), lane = tid & 63, wr = wid >> 2, wc = wid & 3, fr = lane & 15, fq = lane >> 4;
    const int K = g.K, nt = K / BK;
    unsigned voffA[2], voffB[2];
#pragma unroll
    for (int i = 0; i < 2; ++i) { int R, C; stage_rc(tid * 16 + i * 8192, R, C); const int Rb = Epi::PERM ? ((R & ~31) + perm32(R & 31)) : R;
        const int Ra = g.seg ? 62 * (R >> 6) + (R & 63) : R; voffA[i] = (unsigned)(Ra * g.lda + C) * 2u; voffB[i] = (unsigned)(Rb * K + C) * 2u; }
    const size_t kstep = (size_t)(BK * 2);
    const size_t hstep = (size_t)HALF * K * 2;
    const size_t tstep = 2 * hstep;
    const size_t ahs = (size_t)(g.seg ? 124 : 128) * g.lda * 2, ats = 2 * ahs;
#define PG8_APTR(u) ((const char*)g.A + (size_t)(u).pm * ats - (g.seg ? (size_t)g.lda * 2 : 0) + ((u).pn >= g.nsplit ? (size_t)g.a_coloff : 0))
    const unsigned ldsw = (unsigned)wid * 1024u;
    const int aoff = lds_byte(wr * 64 + fr, fq * 8), boff = lds_byte(wc * 32 + fr, fq * 8);
#define PG8_SA(b, h) (((b) * 2 + (h)) * HTB)
#define PG8_SB(b, h) ((4 + (b) * 2 + (h)) * HTB)
#define PG8_STAGE(bufoff, gbase, voff) do { _Pragma("unroll") for (int _i = 0; _i < 2; ++_i) \
        __builtin_amdgcn_global_load_lds((const unsigned*)((const char*)(gbase) + (voff)[_i]), (PG8_LAS unsigned*)(lds + (bufoff) + ldsw + _i * 8192), 16, 0, 0); } while (0)
#define PG8_LDA(dst, b, h) do { _Pragma("unroll") for (int m = 0; m < 4; ++m) _Pragma("unroll") for (int k = 0; k < 2; ++k) dst[m][k] = *(const PG8_LAS bf16x8*)(lds + PG8_SA(b, h) + aoff + m * 2048 + k * 1024); } while (0)
#define PG8_LDB(dst, b, h) do { _Pragma("unroll") for (int n = 0; n < 2; ++n) _Pragma("unroll") for (int k = 0; k < 2; ++k) dst[n][k] = *(const PG8_LAS bf16x8*)(lds + PG8_SB(b, h) + boff + n * 2048 + k * 1024); } while (0)
#define PG8_MMA(ai, bj, At, Bt) do { __builtin_amdgcn_s_setprio(1); _Pragma("unroll") for (int m = 0; m < 4; ++m) _Pragma("unroll") for (int n = 0; n < 2; ++n) _Pragma("unroll") for (int k = 0; k < 2; ++k) \
        acc[ai][bj][m][n] = __builtin_amdgcn_mfma_f32_16x16x32_bf16(Bt[n][k], At[m][k], acc[ai][bj][m][n], 0, 0, 0); __builtin_amdgcn_s_setprio(0); } while (0)
#define PG8_WAIT_V(n) asm volatile("s_waitcnt vmcnt(" #n ")" ::: "memory")
#define PG8_WAIT_L(n) asm volatile("s_waitcnt lgkmcnt(" #n ")" ::: "memory")
#define PG8_BAR __builtin_amdgcn_s_barrier()
#define PG8_SCHED __builtin_amdgcn_sched_barrier(0)
    Unit cur, nxt; int ui = 0;
    if (!S.next(0, cur)) return;
    f32x4 acc[2][2][4][2];
#pragma unroll
    for (int a = 0; a < 2; ++a)
#pragma unroll
        for (int b = 0; b < 2; ++b)
#pragma unroll
            for (int m = 0; m < 4; ++m)
#pragma unroll
                for (int n = 0; n < 2; ++n) acc[a][b][m][n] = (f32x4){0.f, 0.f, 0.f, 0.f};
    bf16x8 At[4][2], B0[2][2], B1[2][2];
    const char* cA = PG8_APTR(cur); const char* cB = (const char*)g.Bt + (size_t)cur.pn * tstep;
    S.a_ready(cur);
    if constexpr (SP2) {
        PG8_STAGE(PG8_SB(0, 0), cB, voffB); PG8_STAGE(PG8_SB(0, 1), cB + hstep, voffB); PG8_STAGE(PG8_SA(0, 0), cA, voffA); PG8_STAGE(PG8_SA(0, 1), cA + ahs, voffA);
        if (wr == 1) PG8_BAR;
        PG8_WAIT_V(2); PG8_BAR;
        PG8_STAGE(PG8_SB(1, 0), cB + kstep, voffB); PG8_STAGE(PG8_SA(1, 0), cA + kstep, voffA); PG8_STAGE(PG8_SB(1, 1), cB + hstep + kstep, voffB);
        PG8_WAIT_V(6); PG8_BAR;
    } else {
        PG8_STAGE(PG8_SB(0, 0), cB, voffB); PG8_STAGE(PG8_SA(0, 0), cA, voffA); PG8_STAGE(PG8_SB(0, 1), cB + hstep, voffB); PG8_STAGE(PG8_SA(0, 1), cA + ahs, voffA);
        if (wr == 1) PG8_BAR;
        PG8_WAIT_V(4); PG8_BAR;
        PG8_STAGE(PG8_SB(1, 0), cB + kstep, voffB); PG8_STAGE(PG8_SA(1, 0), cA + kstep, voffA); PG8_STAGE(PG8_SB(1, 1), cB + hstep + kstep, voffB);
        PG8_WAIT_V(6); PG8_BAR;
    }
    for (;;) {
        const bool has_next = S.next(ui + 1, nxt);
        const char* nA = has_next ? PG8_APTR(nxt) : cA; const char* nB = has_next ? (const char*)g.Bt + (size_t)nxt.pn * tstep : cB;
        for (int t = 0; t < nt; t += 2) {
            if (g.kflags && t == g.kwait_t) {
                const int pd_ = cur.pm, ks_ = cur.pn >> 2, p0_ = (256 * pd_) / 248, p1_ = (256 * pd_ + 255) / 248;
                for (int pp_ = p0_; pp_ <= p1_; ++pp_) if (pp_ < 19) { const unsigned* f_ = g.kflags + (pp_ * 2 + ks_) * 64; unsigned sp_ = 0;
                    while (__hip_atomic_load(f_, __ATOMIC_RELAXED, __HIP_MEMORY_SCOPE_AGENT) == 0u) { __builtin_amdgcn_s_sleep(2); if (++sp_ > (1u << 22)) break; } }
                __builtin_amdgcn_fence(__ATOMIC_ACQUIRE, "agent");
            }
            const bool last = (t == nt - 2);
            const char* a1 = cA + (size_t)(t + 1) * kstep;
            const char* a2 = last ? nA : cA + (size_t)(t + 2) * kstep; const char* b2 = last ? nB : cB + (size_t)(t + 2) * kstep;
            const char* a3 = a2 + kstep; const char* b3 = b2 + kstep;
            if (last && has_next) S.a_ready(nxt);
            if constexpr (SP2) {
            PG8_LDB(B0, 0, 0); PG8_LDB(B1, 0, 1); PG8_SCHED; PG8_LDA(At, 0, 0); PG8_STAGE(PG8_SA(1, 1), a1 + ahs, voffA);
            PG8_WAIT_V(8); PG8_WAIT_L(0); PG8_BAR; PG8_MMA(0, 0, At, B0); PG8_MMA(0, 1, At, B1); PG8_BAR; PG8_SCHED;
            PG8_LDA(At, 0, 1); PG8_STAGE(PG8_SB(0, 0), b2, voffB); PG8_STAGE(PG8_SB(0, 1), b2 + hstep, voffB); PG8_STAGE(PG8_SA(0, 0), a2, voffA);
            PG8_WAIT_V(8); PG8_WAIT_L(0); PG8_BAR; PG8_MMA(1, 0, At, B0); PG8_MMA(1, 1, At, B1); PG8_BAR; PG8_SCHED;
            PG8_LDB(B0, 1, 0); PG8_LDB(B1, 1, 1); PG8_SCHED; PG8_LDA(At, 1, 0); PG8_STAGE(PG8_SA(0, 1), a2 + ahs, voffA);
            PG8_WAIT_V(8); PG8_WAIT_L(0); PG8_BAR; PG8_MMA(0, 0, At, B0); PG8_MMA(0, 1, At, B1); PG8_BAR; PG8_SCHED;
            PG8_LDA(At, 1, 1); PG8_STAGE(PG8_SB(1, 0), b3, voffB); PG8_STAGE(PG8_SB(1, 1), b3 + hstep, voffB); PG8_STAGE(PG8_SA(1, 0), a3, voffA);
            PG8_WAIT_V(8); PG8_WAIT_L(0); PG8_BAR; PG8_MMA(1, 0, At, B0); PG8_MMA(1, 1, At, B1); PG8_BAR; PG8_SCHED;
            } else {
            PG8_LDB(B0, 0, 0); PG8_SCHED; PG8_LDA(At, 0, 0); PG8_STAGE(PG8_SA(1, 1), a1 + ahs, voffA);
            PG8_WAIT_L(8); PG8_BAR; PG8_WAIT_L(0); PG8_MMA(0, 0, At, B0); PG8_BAR; PG8_SCHED;
            PG8_LDB(B1, 0, 1); PG8_STAGE(PG8_SB(0, 0), b2, voffB);
            PG8_BAR; PG8_WAIT_L(0); PG8_MMA(0, 1, At, B1); PG8_BAR;
            PG8_LDA(At, 0, 1); PG8_STAGE(PG8_SA(0, 0), a2, voffA);
            PG8_BAR; PG8_WAIT_L(0); PG8_MMA(1, 0, At, B0); PG8_BAR; PG8_SCHED;
            PG8_STAGE(PG8_SB(0, 1), b2 + hstep, voffB);
            PG8_WAIT_V(6); PG8_BAR; PG8_MMA(1, 1, At, B1); PG8_BAR;
            PG8_LDB(B0, 1, 0); PG8_SCHED; PG8_LDA(At, 1, 0); PG8_STAGE(PG8_SA(0, 1), a2 + ahs, voffA);
            PG8_WAIT_L(8); PG8_BAR; PG8_WAIT_L(0); PG8_MMA(0, 0, At, B0); PG8_BAR; PG8_SCHED;
            PG8_LDB(B1, 1, 1); PG8_STAGE(PG8_SB(1, 0), b3, voffB);
            PG8_BAR; PG8_WAIT_L(0); PG8_MMA(0, 1, At, B1); PG8_BAR;
            PG8_LDA(At, 1, 1); PG8_STAGE(PG8_SA(1, 0), a3, voffA);
            PG8_BAR; PG8_WAIT_L(0); PG8_MMA(1, 0, At, B0); PG8_BAR; PG8_SCHED;
            PG8_STAGE(PG8_SB(1, 1), b3 + hstep, voffB);
            PG8_WAIT_V(6); PG8_BAR; PG8_MMA(1, 1, At, B1); PG8_BAR;
            }
        }
        if constexpr (ALIGN_EPI) { if (wr == 0) PG8_BAR; }
        if constexpr (!Epi::AFTER_DRAIN) { E(acc, cur, wr, wc, fr, fq); S.done(cur); }
        if (!has_next) break;
#pragma unroll
        for (int a = 0; a < 2; ++a)
#pragma unroll
            for (int b = 0; b < 2; ++b)
#pragma unroll
                for (int m = 0; m < 4; ++m)
#pragma unroll
                    for (int n = 0; n < 2; ++n) acc[a][b][m][n] = (f32x4){0.f, 0.f, 0.f, 0.f};
        cur = nxt; cA = nA; cB = nB; ++ui;
        if constexpr (ALIGN_EPI) { if (wr == 1) PG8_BAR; }
    }
    PG8_WAIT_V(0);
    if constexpr (!ALIGN_EPI) { if (wr == 0) PG8_BAR; }
    PG8_BAR;
    if constexpr (Epi::AFTER_DRAIN) { E.fused(acc, cur, wr, wc, fr, fq, lds, wid, lane); S.done(cur); }
#undef PG8_APTR
#undef PG8_SA
#undef PG8_SB
#undef PG8_STAGE
#undef PG8_LDA
#undef PG8_LDB
#undef PG8_MMA
#undef PG8_WAIT_V
#undef PG8_WAIT_L
#undef PG8_BAR
#undef PG8_SCHED
}
}

#define DI __device__ __forceinline__
#define LAS __attribute__((address_space(3)))
typedef unsigned short bf16_t;
typedef short bf16x8 __attribute__((ext_vector_type(8)));
typedef short s16x4 __attribute__((ext_vector_type(4)));
typedef float f32x4 __attribute__((ext_vector_type(4)));
typedef float f32x2 __attribute__((ext_vector_type(2)));
typedef unsigned u32x4 __attribute__((ext_vector_type(4)));
typedef unsigned u32x2 __attribute__((ext_vector_type(2)));
typedef __bf16 bf2_t __attribute__((ext_vector_type(2)));

constexpr int NTOK = 6144, NPROMPT = 4096, DM = 1024, INW = 2304, DFF = 2816, UPW = 5632;
constexpr int NTHR = 512, NWAVE = 8;
constexpr float EPS = 1e-6f;

constexpr size_t OFF_BAR = 0;
constexpr size_t OFF_MOD = 65536;
constexpr size_t OFF_WIN = 1u << 20;
constexpr size_t OFF_WOUT = OFF_WIN + (size_t)2304 * 1024 * 2;
constexpr size_t OFF_WUP = OFF_WOUT + (size_t)1024 * 1024 * 2;
constexpr size_t OFF_WDOWN = OFF_WUP + (size_t)5632 * 1024 * 2;
constexpr size_t OFF_CAK = OFF_WDOWN + (size_t)1024 * 2816 * 2;
constexpr size_t OFF_CAV = OFF_CAK + (size_t)2 * 256 * 512 * 2;
constexpr size_t OFF_CBK = OFF_CAV + (size_t)2 * 256 * 512 * 2;
constexpr size_t OFF_CBV = OFF_CBK + (size_t)2 * 256 * 128 * 2;
constexpr size_t OFF_H = OFF_CBV + (size_t)2 * 256 * 128 * 2;
constexpr size_t OFF_Z = OFF_H + (size_t)NTOK * 1024 * 2;
constexpr size_t OFF_O = OFF_Z + (size_t)NTOK * 2304 * 2;
constexpr size_t OFF_SS = OFF_O + (size_t)NTOK * 1024 * 2;
constexpr size_t OFF_MIX = OFF_SS + (size_t)NTOK * 16 * 4;
constexpr size_t OFF_ACT = OFF_MIX + (size_t)2 * NTOK * 1024 * 4;
constexpr size_t WS_END = OFF_ACT + (size_t)NTOK * 2816 * 2;

constexpr size_t OUT_Y = 0, OUT_AK = (size_t)NTOK * 1024, OUT_AV = OUT_AK + (size_t)NPROMPT * 512, OUT_BK = OUT_AV + (size_t)NPROMPT * 512, OUT_BV = OUT_BK + (size_t)NPROMPT * 128;

struct P {
    const float* in[24];
    float* out;
    unsigned char* ws;
};
enum { I_XP = 0, I_XS, I_CAK, I_CAV, I_CBK, I_CBV, I_C, I_CCTX, I_WMOD, I_BMOD, I_GMIXPRE, I_GMIXPOST, I_GFFNPRE, I_GFFNPOST, I_WIN, I_RPB, I_SINK, I_GGA, I_GGB, I_WOUT, I_WUP, I_CONVW, I_CONVB, I_WDOWN };

constexpr int LDS_MAIN = 131072;
constexpr int LDS_BYTES = LDS_MAIN + 256;
constexpr int LDP = 80;

DI unsigned pk_bf16(float lo, float hi) { f32x2 v = {lo, hi}; bf2_t r = __builtin_convertvector(v, bf2_t); return __builtin_bit_cast(unsigned, r); }
DI float wave_sum(float v) {
#pragma unroll
    for (int o = 1; o < 64; o <<= 1) v += __shfl_xor(v, o);
    return v;
}
DI float silu_f(float x) { return x * __builtin_amdgcn_rcpf(1.f + __builtin_amdgcn_exp2f(x * -1.4426950408889634f)); }
DI const float* xrow_ptr(const P& p, int row) { return row < NPROMPT ? p.in[I_XP] + (size_t)row * DM : p.in[I_XS] + (size_t)(row - NPROMPT) * DM; }
DI int cond_of(int row) { return row < NPROMPT ? 0 : 1 + ((row - NPROMPT) >> 10); }
DI float dot4(f32x4 a) { return (a.x * a.x + a.y * a.y) + (a.z * a.z + a.w * a.w); }
DI float hsum4(f32x4 a) { return (a.x + a.y) + (a.z + a.w); }
#define XB_TMO      128
#define XB_XCNT(j)  (256  + 64 * (j))
#define XB_XSUB(j)  (1280 + 64 * (j))
#define XB_XGEN(j)  (2304 + 64 * (j))
#define XB_TOP      3328
#define XB_TOPGEN   3392
#define XCD_BAR_WORDS 3456
#define XB_SPIN_CAP (1u << 18)

__device__ __forceinline__ unsigned xb_ld(unsigned* p)              { return __hip_atomic_load(p, __ATOMIC_RELAXED, __HIP_MEMORY_SCOPE_AGENT); }
__device__ __forceinline__ unsigned xb_add(unsigned* p, unsigned v) { return __hip_atomic_fetch_add(p, v, __ATOMIC_RELAXED, __HIP_MEMORY_SCOPE_AGENT); }
__device__ __forceinline__ unsigned xb_xcc_id() { return (unsigned)__builtin_amdgcn_s_getreg((3 << 11) | 20) & 0xFu; }
#define XB_SPIN(cond, bar) do { unsigned _sp = 0; while (cond) { __builtin_amdgcn_s_sleep(1); \
    if ((++_sp & 255u) == 0u) { if (xb_ld(&(bar)[XB_TMO])) break; if (_sp > XB_SPIN_CAP) { atomicAdd(&(bar)[XB_TMO], 1u); break; } } } } while (0)

struct XcdBarrier {
    unsigned* bar; unsigned x;
    volatile LAS unsigned* st;
};

__device__ __forceinline__ XcdBarrier xcd_barrier_post(unsigned* bar, volatile LAS unsigned* st) {
    XcdBarrier b; b.bar = bar; b.x = xb_xcc_id(); b.st = st;
    if (threadIdx.x == 0) (void)xb_add(&bar[XB_XCNT(b.x)], 1u);
    return b;
}
__device__ __forceinline__ void xcd_barrier_complete(unsigned* bar, unsigned x, unsigned& nloc, unsigned& nx) {
    const unsigned G = gridDim.x * gridDim.y * gridDim.z;
    unsigned sum, cnt, mine, sp = 0u;
    for (;;) {
        sum = 0u; cnt = 0u; mine = 0u;
#pragma unroll
        for (unsigned j = 0; j < 16; ++j) { const unsigned c = xb_ld(&bar[XB_XCNT(j)]); sum += c; cnt += (c > 0u) ? 1u : 0u; mine = (j == x) ? c : mine; }
        if (sum == G) break;
        __builtin_amdgcn_s_sleep(1);
        if ((++sp & 255u) == 0u) { if (xb_ld(&bar[XB_TMO])) break; if (sp > XB_SPIN_CAP) { atomicAdd(&bar[XB_TMO], 1u); break; } }
    }
    nloc = mine > 0u ? mine : 1u; nx = cnt > 0u ? cnt : 1u;
}

__device__ __forceinline__ void xcd_barrier(const XcdBarrier& b) {
    asm volatile("s_waitcnt vmcnt(0)" ::: "memory");
    __syncthreads();
    if (threadIdx.x == 0) {
        unsigned* bar = b.bar;
        __builtin_amdgcn_s_waitcnt(0);
        unsigned nloc = b.st[0], nx = b.st[1];
        if (nloc == 0u) { xcd_barrier_complete(bar, b.x, nloc, nx); b.st[0] = nloc; b.st[1] = nx; }
        const unsigned old = xb_add(&bar[XB_XSUB(b.x)], 1u);
        const unsigned gen = old / nloc;
        if (old + 1u == (gen + 1u) * nloc) {
            __builtin_amdgcn_fence(__ATOMIC_RELEASE, "agent");
            asm volatile("s_waitcnt vmcnt(0)" ::: "memory");
            const unsigned og = xb_add(&bar[XB_TOP], 1u);
            const unsigned tg = og / nx;
            if (og + 1u == (tg + 1u) * nx) xb_add(&bar[XB_TOPGEN], 1u);
            else XB_SPIN(xb_ld(&bar[XB_TOPGEN]) == tg, bar);
            __builtin_amdgcn_fence(__ATOMIC_ACQUIRE, "agent");
            xb_add(&bar[XB_XGEN(b.x)], 1u);
            asm volatile("s_waitcnt vmcnt(0)" ::: "memory");
        } else {
            XB_SPIN(xb_ld(&bar[XB_XGEN(b.x)]) == gen, bar);
            __builtin_amdgcn_fence(__ATOMIC_ACQUIRE, "agent");
            asm volatile("s_waitcnt vmcnt(0)" ::: "memory");
        }
    }
    __syncthreads();
}

DI void p0_adaln(const P& p, int item, float* scr, int tid) {
    const int lane = tid & 63, w = tid >> 6;
    const int c4 = (tid & 7) * 4, rg = tid >> 3;
    const int col = item * 32 + c4;
    const float* wm = p.in[I_WMOD]; const float* cctx = p.in[I_CCTX]; const float* c = p.in[I_C];
    f32x4 wv[16];
#pragma unroll
    for (int i = 0; i < 16; ++i) wv[i] = __builtin_nontemporal_load((const f32x4*)(wm + (size_t)(rg + 64 * i) * 6144 + col));
    f32x4 a0 = {0, 0, 0, 0}, a1 = {0, 0, 0, 0}, a2 = {0, 0, 0, 0};
#pragma unroll
    for (int i = 0; i < 16; ++i) {
        const int row = rg + 64 * i;
        const float s0 = silu_f(cctx[row]), s1 = silu_f(c[row]), s2 = silu_f(c[1024 + row]);
        a0 += wv[i] * s0; a1 += wv[i] * s1; a2 += wv[i] * s2;
    }
#pragma unroll
    for (int o = 8; o < 64; o <<= 1) {
#pragma unroll
        for (int e = 0; e < 4; ++e) { a0[e] += __shfl_xor(a0[e], o); a1[e] += __shfl_xor(a1[e], o); a2[e] += __shfl_xor(a2[e], o); }
    }
    if (lane < 8) { *(f32x4*)(scr + (w * 3 + 0) * 32 + c4) = a0; *(f32x4*)(scr + (w * 3 + 1) * 32 + c4) = a1; *(f32x4*)(scr + (w * 3 + 2) * 32 + c4) = a2; }
    __syncthreads();
    if (tid < 96) {
        const int cond = tid >> 5, cc = tid & 31; float s = 0.f;
#pragma unroll
        for (int ww = 0; ww < 8; ++ww) s += scr[(ww * 3 + cond) * 32 + cc];
        __hip_atomic_store((float*)(p.ws + OFF_MOD) + cond * 6144 + item * 32 + cc, s + p.in[I_BMOD][item * 32 + cc], __ATOMIC_RELAXED, __HIP_MEMORY_SCOPE_AGENT);
    }
    __syncthreads();
}
DI void p0_transpose(const float* W, int N, int srcA, int srcB, int k0, bf16_t* WT, int outrow0, int outK, int outk0, const float* ks, float* scr, int tid) {
    const int c4 = (tid & 63) * 4, r0 = tid >> 6;
    const int scol = c4 < 128 ? srcA + c4 : srcB + (c4 - 128);
    f32x4 v[8];
#pragma unroll
    for (int i = 0; i < 8; ++i) v[i] = *(const f32x4*)(W + (size_t)(k0 + r0 + 8 * i) * N + scol);
#pragma unroll
    for (int i = 0; i < 8; ++i) { if (ks) v[i] *= ks[k0 + r0 + 8 * i]; *(f32x4*)(scr + (r0 + 8 * i) * 260 + c4) = v[i]; }
    __syncthreads();
    const int n = tid >> 1, kh = (tid & 1) * 32;
    const float* s = scr + kh * 260 + n;
#pragma unroll
    for (int q = 0; q < 4; ++q) {
        u32x4 o;
        o.x = pk_bf16(s[(8 * q + 0) * 260], s[(8 * q + 1) * 260]); o.y = pk_bf16(s[(8 * q + 2) * 260], s[(8 * q + 3) * 260]);
        o.z = pk_bf16(s[(8 * q + 4) * 260], s[(8 * q + 5) * 260]); o.w = pk_bf16(s[(8 * q + 6) * 260], s[(8 * q + 7) * 260]);
        *(u32x4*)(WT + (size_t)(outrow0 + n) * outK + outk0 + kh + 8 * q) = o;
    }
    __syncthreads();
}
DI void publish_inc(unsigned* cnt, int tid) {
    asm volatile("s_waitcnt vmcnt(0)" ::: "memory");
    __syncthreads();
    if (tid == 0) { __builtin_amdgcn_fence(__ATOMIC_RELEASE, "agent"); asm volatile("s_waitcnt vmcnt(0)" ::: "memory"); (void)xb_add(cnt, 1u); }
}
DI void publish_inc_wt(unsigned* cnt, int tid) {
    asm volatile("s_waitcnt vmcnt(0)" ::: "memory");
    __syncthreads();
    if (tid == 0) (void)xb_add(cnt, 1u);
}
DI void wait_count(unsigned* cnt, unsigned want, int tid) {
    if (tid == 0) {
        unsigned sp = 0; while (xb_ld(cnt) < want) { __builtin_amdgcn_s_sleep(2); if (++sp > (1u << 22)) break; }
        __builtin_amdgcn_fence(__ATOMIC_ACQUIRE, "agent"); asm volatile("s_waitcnt vmcnt(0)" ::: "memory");
    }
    __syncthreads();
}
constexpr int T_IN = 144, T_OUT = 64, T_UP = 352, T_DOWN = 176;
DI void tr_win(const P& p, int r, float* scr, int tid) { const int kb = r / 9, nbk = r % 9; p0_transpose(p.in[I_WIN], INW, nbk * 256, nbk * 256 + 128, kb * 64, (bf16_t*)(p.ws + OFF_WIN), nbk * 256, 1024, kb * 64, nullptr, scr, tid); }
DI void tr_wout(const P& p, int r, float* scr, int tid) { const int kb = r >> 2, nbk = r & 3, half = kb >> 3;
    p0_transpose(p.in[I_WOUT], 1024, nbk * 256, nbk * 256 + 128, kb * 64, (bf16_t*)(p.ws + OFF_WOUT), half * 1024 + nbk * 256, 512, (kb & 7) * 64, half ? p.in[I_GGB] - 512 : p.in[I_GGA], scr, tid); }
DI void tr_wup(const P& p, int r, float* scr, int tid) { const int kb = r / 22, tl = r % 22; p0_transpose(p.in[I_WUP], UPW, tl * 128, DFF + tl * 128, kb * 64, (bf16_t*)(p.ws + OFF_WUP), tl * 256, 1024, kb * 64, nullptr, scr, tid); }
DI void tr_wdown(const P& p, int r, float* scr, int tid) { const int kb = r >> 2, nbk = r & 3, sp = kb / 22;
    p0_transpose(p.in[I_WDOWN], 1024, nbk * 256, nbk * 256 + 128, kb * 64, (bf16_t*)(p.ws + OFF_WDOWN), sp * 1024 + nbk * 256, 1408, (kb - 22 * sp) * 64, nullptr, scr, tid); }
struct TrDesc { const float* W; const float* ks; bf16_t* WT; int N, srcA, srcB, k0, outrow0, outK, outk0; };
DI TrDesc tr_desc(const P& p, int r) {
    TrDesc d; d.ks = nullptr;
    if (r < T_IN) { const int kb = r / 9, nbk = r % 9; d.W = p.in[I_WIN]; d.N = INW; d.srcA = nbk * 256; d.srcB = nbk * 256 + 128; d.k0 = kb * 64; d.WT = (bf16_t*)(p.ws + OFF_WIN); d.outrow0 = nbk * 256; d.outK = 1024; d.outk0 = kb * 64; return d; }
    r -= T_IN;
    if (r < T_OUT) { const int kb = r >> 2, nbk = r & 3, half = kb >> 3; d.W = p.in[I_WOUT]; d.N = 1024; d.srcA = nbk * 256; d.srcB = nbk * 256 + 128; d.k0 = kb * 64; d.WT = (bf16_t*)(p.ws + OFF_WOUT); d.outrow0 = half * 1024 + nbk * 256; d.outK = 512; d.outk0 = (kb & 7) * 64;
        d.ks = half ? p.in[I_GGB] - 512 : p.in[I_GGA]; return d; }
    r -= T_OUT;
    if (r < T_UP) { const int kb = r / 22, tl = r % 22; d.W = p.in[I_WUP]; d.N = UPW; d.srcA = tl * 128; d.srcB = DFF + tl * 128; d.k0 = kb * 64; d.WT = (bf16_t*)(p.ws + OFF_WUP); d.outrow0 = tl * 256; d.outK = 1024; d.outk0 = kb * 64; return d; }
    r -= T_UP;
    { const int kb = r >> 2, nbk = r & 3, sp = kb / 22; d.W = p.in[I_WDOWN]; d.N = 1024; d.srcA = nbk * 256; d.srcB = nbk * 256 + 128; d.k0 = kb * 64; d.WT = (bf16_t*)(p.ws + OFF_WDOWN); d.outrow0 = sp * 1024 + nbk * 256; d.outK = 1408; d.outk0 = (kb - 22 * sp) * 64; return d; }
}
DI void tr_load(const TrDesc& d, f32x4 (&v)[8], int tid) {
    const int c4 = (tid & 63) * 4, r0 = tid >> 6; const int scol = c4 < 128 ? d.srcA + c4 : d.srcB + (c4 - 128);
#pragma unroll
    for (int i = 0; i < 8; ++i) { v[i] = __builtin_nontemporal_load((const f32x4*)(d.W + (size_t)(d.k0 + r0 + 8 * i) * d.N + scol)); }
}
DI void tr_range(const P& p, int first, int end, int stride, float* scr, int tid) {
    if (first >= end) return;
    f32x4 v[8];
    TrDesc d = tr_desc(p, first);
    tr_load(d, v, tid);
    for (int it = first; it < end; it += stride) {
        const int c4 = (tid & 63) * 4, r0 = tid >> 6;
#pragma unroll
        for (int i = 0; i < 8; ++i) { f32x4 t = v[i]; if (d.ks) t *= d.ks[d.k0 + r0 + 8 * i]; *(f32x4*)(scr + (r0 + 8 * i) * 260 + c4) = t; }
        const TrDesc cur = d;
        if (it + stride < end) { d = tr_desc(p, it + stride); tr_load(d, v, tid); }
        __syncthreads();
        const int n = tid >> 1, kh = (tid & 1) * 32;
        const float* sp = scr + kh * 260 + n;
#pragma unroll
        for (int q = 0; q < 4; ++q) {
            u32x4 o;
            o.x = pk_bf16(sp[(8 * q + 0) * 260], sp[(8 * q + 1) * 260]); o.y = pk_bf16(sp[(8 * q + 2) * 260], sp[(8 * q + 3) * 260]);
            o.z = pk_bf16(sp[(8 * q + 4) * 260], sp[(8 * q + 5) * 260]); o.w = pk_bf16(sp[(8 * q + 6) * 260], sp[(8 * q + 7) * 260]);
            *(u32x4*)(cur.WT + (size_t)(cur.outrow0 + n) * cur.outK + cur.outk0 + kh + 8 * q) = o;
        }
        __syncthreads();
    }
}
DI void p0_phase(const P& p, int bid, int nb, float* scr, int tid, unsigned* cntA) {
    constexpr int T_AD = 192, N_CV = 80;
    constexpr int NITEMS = T_AD + N_CV;
    for (int it = bid; it < NITEMS; it += nb) {
        int r = it;
        if (r < T_AD) { p0_adaln(p, r, scr, tid); if (r < 64) publish_inc_wt(cntA, tid); continue; }
        r -= T_AD;
        {
            const size_t e0 = (size_t)r * 8192;
#pragma unroll
            for (int i = 0; i < 2; ++i) {
                const size_t e = e0 + (size_t)(i * NTHR + tid) * 8;
                const float* src; bf16_t* dst;
                if (e < 262144) { src = p.in[I_CAK] + e; dst = (bf16_t*)(p.ws + OFF_CAK) + e; }
                else if (e < 524288) { src = p.in[I_CAV] + (e - 262144); dst = (bf16_t*)(p.ws + OFF_CAV) + (e - 262144); }
                else if (e < 589824) { src = p.in[I_CBK] + (e - 524288); dst = (bf16_t*)(p.ws + OFF_CBK) + (e - 524288); }
                else { src = p.in[I_CBV] + (e - 589824); dst = (bf16_t*)(p.ws + OFF_CBV) + (e - 589824); }
                const f32x4 a = *(const f32x4*)src, b = *(const f32x4*)(src + 4);
                u32x4 o; o.x = pk_bf16(a.x, a.y); o.y = pk_bf16(a.z, a.w); o.z = pk_bf16(b.x, b.y); o.w = pk_bf16(b.z, b.w);
                *(u32x4*)dst = o;
            }
        }
    }
    __syncthreads();
    if (nb == 256) { if (bid >= 192) tr_range(p, bid - 192, T_IN, 64, scr, tid); }
    else tr_range(p, bid, T_IN, nb, scr, tid);
}

DI f32x4 ld_bf4(const bf16_t* p) { const u32x2 r = *(const u32x2*)p; f32x4 o; o.x = __uint_as_float(r.x << 16); o.y = __uint_as_float(r.x & 0xffff0000u); o.z = __uint_as_float(r.y << 16); o.w = __uint_as_float(r.y & 0xffff0000u); return o; }
template <int RP> DI void p1_rows(const P& p, const int gw, const int ngw, const int rend, const int lane, unsigned* waitcnt = nullptr, int tid = 0) {
    bf16_t* H = (bf16_t*)(p.ws + OFF_H);
    for (int row0 = gw; row0 < rend; row0 += RP * ngw) {
        f32x4 v[RP][4];
#pragma unroll
        for (int k = 0; k < RP; ++k) { const int row = row0 + k * ngw; if (row < rend) { const float* x = xrow_ptr(p, row);
#pragma unroll
            for (int j = 0; j < 4; ++j) v[k][j] = __builtin_nontemporal_load((const f32x4*)(x + 4 * lane + 256 * j)); } }
        if (waitcnt) { wait_count(waitcnt, 64u, tid); waitcnt = nullptr; }
#pragma unroll
        for (int k = 0; k < RP; ++k) { const int row = row0 + k * ngw; if (row < rend) {
            const float* mod = (const float*)(p.ws + OFF_MOD) + cond_of(row) * 6144;
            f32x4 g[4], sh[4], sc[4];
#pragma unroll
            for (int j = 0; j < 4; ++j) { const int col = 4 * lane + 256 * j; g[j] = *(const f32x4*)(p.in[I_GMIXPRE] + col); sh[j] = *(const f32x4*)(mod + col); sc[j] = *(const f32x4*)(mod + 1024 + col); }
            float s = 0.f;
#pragma unroll
            for (int j = 0; j < 4; ++j) s += dot4(v[k][j]);
            const float rstd = rsqrtf(wave_sum(s) * (1.f / DM) + EPS);
#pragma unroll
            for (int j = 0; j < 4; ++j) {
                const int col = 4 * lane + 256 * j;
                const f32x4 h = (v[k][j] * rstd) * g[j] * (sc[j] + 1.f) + sh[j];
                u32x2 o; o.x = pk_bf16(h.x, h.y); o.y = pk_bf16(h.z, h.w);
                *(u32x2*)(H + (size_t)row * DM + col) = o;
            } } }
    }
}
template <int RP> DI void p5_rows(const P& p, const int gw, const int ngw, const int rend, const int lane, unsigned* waitcnt = nullptr, int tid = 0) {
    bf16_t* H = (bf16_t*)(p.ws + OFF_H); const bf16_t* MA = (const bf16_t*)(p.ws + OFF_MIX); const bf16_t* MB = MA + (size_t)NTOK * DM; const float* SS = (const float*)(p.ws + OFF_SS);
    for (int row0 = gw; row0 < rend; row0 += RP * ngw) {
        f32x4 xv[RP][4]; u32x2 ma[RP][4], mb[RP][4]; float sv[RP];
#pragma unroll
        for (int k = 0; k < RP; ++k) { const int row = row0 + k * ngw; if (row < rend) { const float* x = xrow_ptr(p, row);
            sv[k] = (lane < 16) ? SS[(size_t)row * 16 + lane] : 0.f;
#pragma unroll
            for (int j = 0; j < 4; ++j) { const int col = 4 * lane + 256 * j; xv[k][j] = __builtin_nontemporal_load((const f32x4*)(x + col)); } } }
        if (waitcnt) { wait_count(waitcnt, 8u, tid); waitcnt = nullptr; }
#pragma unroll
        for (int k = 0; k < RP; ++k) { const int row = row0 + k * ngw; if (row < rend) {
#pragma unroll
            for (int j = 0; j < 4; ++j) { const int col = 4 * lane + 256 * j; ma[k][j] = __builtin_nontemporal_load((const u32x2*)(MA + (size_t)row * DM + col)); mb[k][j] = __builtin_nontemporal_load((const u32x2*)(MB + (size_t)row * DM + col)); } } }
#pragma unroll
        for (int k = 0; k < RP; ++k) { const int row = row0 + k * ngw; if (row < rend) {
            const float* mod = (const float*)(p.ws + OFF_MOD) + cond_of(row) * 6144;
            float sa = (lane < 8) ? sv[k] : 0.f, sb = (lane >= 8) ? sv[k] : 0.f;
            sa = wave_sum(sa); sb = wave_sum(sb);
            const float rsa = rsqrtf(sa * (1.f / 512.f) + EPS), rsb = rsqrtf(sb * (1.f / 512.f) + EPS);
            f32x4 mx[4]; float sm = 0.f;
#pragma unroll
            for (int j = 0; j < 4; ++j) {
                f32x4 a, b; a.x = __uint_as_float(ma[k][j].x << 16); a.y = __uint_as_float(ma[k][j].x & 0xffff0000u); a.z = __uint_as_float(ma[k][j].y << 16); a.w = __uint_as_float(ma[k][j].y & 0xffff0000u);
                b.x = __uint_as_float(mb[k][j].x << 16); b.y = __uint_as_float(mb[k][j].x & 0xffff0000u); b.z = __uint_as_float(mb[k][j].y << 16); b.w = __uint_as_float(mb[k][j].y & 0xffff0000u);
                mx[j] = a * rsa + b * rsb; sm += dot4(mx[j]); }
            const float rstd_m = rsqrtf(wave_sum(sm) * (1.f / DM) + EPS);
            float s = 0.f;
#pragma unroll
            for (int j = 0; j < 4; ++j) {
                const int col = 4 * lane + 256 * j;
                const f32x4 g = *(const f32x4*)(p.in[I_GMIXPOST] + col), gt = *(const f32x4*)(mod + 2048 + col);
                xv[k][j] = xv[k][j] + gt * ((mx[j] * rstd_m) * g);
                { u32x2 ox; ox.x = pk_bf16(xv[k][j].x, xv[k][j].y); ox.y = pk_bf16(xv[k][j].z, xv[k][j].w); *(u32x2*)((bf16_t*)(p.ws + OFF_Z) + (size_t)row * DM + col) = ox; }
                s += dot4(xv[k][j]);
            }
            const float rstd = rsqrtf(wave_sum(s) * (1.f / DM) + EPS);
#pragma unroll
            for (int j = 0; j < 4; ++j) {
                const int col = 4 * lane + 256 * j;
                const f32x4 g = *(const f32x4*)(p.in[I_GFFNPRE] + col), sh = *(const f32x4*)(mod + 3072 + col), sc = *(const f32x4*)(mod + 4096 + col);
                const f32x4 h = (xv[k][j] * rstd) * g * (sc + 1.f) + sh;
                u32x2 o; o.x = pk_bf16(h.x, h.y); o.y = pk_bf16(h.z, h.w);
                *(u32x2*)(H + (size_t)row * DM + col) = o;
            } } }
    }
}
template <int RP> DI void p8_rows(const P& p, const int gw, const int ngw, const int rend, const int lane, unsigned* waitcnt = nullptr, int tid = 0) {
    const bf16_t* F0 = (const bf16_t*)(p.ws + OFF_MIX); const bf16_t* F1 = F0 + (size_t)NTOK * DM;
    for (int row0 = gw; row0 < rend; row0 += RP * ngw) {
        f32x4 x1[RP][4]; u32x2 fa[RP][4], fb[RP][4];
#pragma unroll
        for (int k = 0; k < RP; ++k) { const int row = row0 + k * ngw; if (row < rend) {
#pragma unroll
            for (int j = 0; j < 4; ++j) { const int col = 4 * lane + 256 * j; x1[k][j] = ld_bf4((const bf16_t*)(p.ws + OFF_Z) + (size_t)row * DM + col); } } }
        if (waitcnt) { wait_count(waitcnt, 8u, tid); waitcnt = nullptr; }
#pragma unroll
        for (int k = 0; k < RP; ++k) { const int row = row0 + k * ngw; if (row < rend) {
#pragma unroll
            for (int j = 0; j < 4; ++j) { const int col = 4 * lane + 256 * j; fa[k][j] = __builtin_nontemporal_load((const u32x2*)(F0 + (size_t)row * DM + col)); fb[k][j] = __builtin_nontemporal_load((const u32x2*)(F1 + (size_t)row * DM + col)); } } }
#pragma unroll
        for (int k = 0; k < RP; ++k) { const int row = row0 + k * ngw; if (row < rend) {
            const float* mod = (const float*)(p.ws + OFF_MOD) + cond_of(row) * 6144;
            f32x4 fv[4]; float s = 0.f;
#pragma unroll
            for (int j = 0; j < 4; ++j) {
                f32x4 a, b; a.x = __uint_as_float(fa[k][j].x << 16); a.y = __uint_as_float(fa[k][j].x & 0xffff0000u); a.z = __uint_as_float(fa[k][j].y << 16); a.w = __uint_as_float(fa[k][j].y & 0xffff0000u);
                b.x = __uint_as_float(fb[k][j].x << 16); b.y = __uint_as_float(fb[k][j].x & 0xffff0000u); b.z = __uint_as_float(fb[k][j].y << 16); b.w = __uint_as_float(fb[k][j].y & 0xffff0000u);
                fv[j] = a + b; s += dot4(fv[j]); }
            const float rstd_f = rsqrtf(wave_sum(s) * (1.f / DM) + EPS);
#pragma unroll
            for (int j = 0; j < 4; ++j) {
                const int col = 4 * lane + 256 * j;
                const f32x4 g = *(const f32x4*)(p.in[I_GFFNPOST] + col), gt = *(const f32x4*)(mod + 5120 + col);
                __builtin_nontemporal_store(x1[k][j] + gt * ((fv[j] * rstd_f) * g), (f32x4*)(p.out + OUT_Y + (size_t)row * DM + col));
            } } }
    }
}

struct EpiInproj {
    static constexpr bool PERM = false, AFTER_DRAIN = false;
    bf16_t* Z; float* out;
    DI void operator()(const f32x4 (&acc)[2][2][4][2], const pg8::Unit& u, int wr, int wc, int fr, int fq) const {
        const bool sample = (u.pm >= 16);
        const int pn = u.pn;
        const bool isq = (pn < 2) || (pn == 6) || (pn == 7);
        float inv[4];
#pragma unroll
        for (int e = 0; e < 4; ++e) inv[e] = __builtin_amdgcn_exp2f(-(float)(fq * 4 + e) * (13.287712379549449f / 16.f)) * 0.15915494309189535f;
#pragma unroll
        for (int bj = 0; bj < 2; ++bj) {
            const bool rope = sample && (pn == 6 || pn == 7 || (pn == 8 && bj == 0));
            float* fo = nullptr; int fpitch = 0, fcol = 0;
            if (!sample) {
                if (pn == 2 || pn == 3) { fo = out + OUT_AK; fpitch = 512; fcol = (pn - 2) * 256 + bj * 128; }
                else if (pn == 4 || pn == 5) { fo = out + OUT_AV; fpitch = 512; fcol = (pn - 4) * 256 + bj * 128; }
                else if (pn == 8) { fo = out + (bj == 0 ? OUT_BK : OUT_BV); fpitch = 128; fcol = 0; }
            }
            const int zcol = pn * 256 + bj * 128 + wc * 32 + 4 * fq;
            const float qs = isq ? 0.18033688011112042f : 1.f;
#pragma unroll
            for (int ai = 0; ai < 2; ++ai)
#pragma unroll
                for (int m = 0; m < 4; ++m) {
                    const int grow = u.pm * 256 + ai * 128 + wr * 64 + m * 16 + fr;
                    f32x4 v0 = acc[ai][bj][m][0], v1 = acc[ai][bj][m][1];
                    if (fo) { float* fp = fo + (size_t)grow * fpitch + fcol + wc * 32 + 4 * fq; __builtin_nontemporal_store(v0, (f32x4*)fp); __builtin_nontemporal_store(v1, (f32x4*)(fp + 16)); }
                    if (rope) {
                        const int pos = (grow - NPROMPT) & 1023; const float ps = (wc & 1) ? (float)(pos & 63) : (float)(pos >> 6);
#pragma unroll
                        for (int e = 0; e < 4; ++e) {
                            float a = ps * inv[e]; a -= floorf(a);
                            const float cs = __builtin_amdgcn_cosf(a), sn = __builtin_amdgcn_sinf(a);
                            const float x1 = v0[e], x2 = v1[e];
                            v0[e] = x1 * cs - x2 * sn; v1[e] = x2 * cs + x1 * sn;
                        }
                    }
                    v0 *= qs; v1 *= qs;
                    bf16_t* zp = Z + (size_t)grow * INW + zcol;
                    u32x2 o0, o1; o0.x = pk_bf16(v0.x, v0.y); o0.y = pk_bf16(v0.z, v0.w); o1.x = pk_bf16(v1.x, v1.y); o1.y = pk_bf16(v1.z, v1.w);
                    { auto rx = __builtin_amdgcn_permlane16_swap(o0.x, o1.x, false, false); auto ry = __builtin_amdgcn_permlane16_swap(o0.y, o1.y, false, false);
                      u32x4 o4; o4.x = rx[0]; o4.y = ry[0]; o4.z = rx[1]; o4.w = ry[1];
                      *(u32x4*)(zp + ((fq & 1) ? 12 : 0)) = o4; }
                }
        }
    }
};
DI void st16_wt(void* ptr, u32x4 v) { asm volatile("global_store_dwordx4 %0, %1, off sc1\n\ts_nop 1" :: "v"(ptr), "v"(v) : "memory"); }
struct EpiF32 {
    static constexpr bool PERM = true, AFTER_DRAIN = false;
    bf16_t* O;
    DI void operator()(const f32x4 (&acc)[2][2][4][2], const pg8::Unit& u, int wr, int wc, int fr, int fq) const {
        bf16_t* base = O + (size_t)(u.pn >> 2) * NTOK * DM + (u.pn & 3) * 256 + wc * 32 + 8 * fq;
#pragma unroll
        for (int ai = 0; ai < 2; ++ai)
#pragma unroll
            for (int m = 0; m < 4; ++m) {
                bf16_t* rp = base + (size_t)(u.pm * 256 + ai * 128 + wr * 64 + m * 16 + fr) * DM;
#pragma unroll
                for (int bj = 0; bj < 2; ++bj) {
                    const f32x4 v0 = acc[ai][bj][m][0], v1 = acc[ai][bj][m][1];
                    u32x4 o; o.x = pk_bf16(v0.x, v0.y); o.y = pk_bf16(v0.z, v0.w); o.z = pk_bf16(v1.x, v1.y); o.w = pk_bf16(v1.z, v1.w);
                    st16_wt(rp + bj * 128, o);
                }
            }
    }
};
DI float dpp_prev(float x) { int u_; asm("" : "=v"(u_)); return __builtin_bit_cast(float, __builtin_amdgcn_update_dpp(u_, __builtin_bit_cast(int, x), 0x121, 0xf, 0xf, true)); }
DI float dpp_next(float x) { int u_; asm("" : "=v"(u_)); return __builtin_bit_cast(float, __builtin_amdgcn_update_dpp(u_, __builtin_bit_cast(int, x), 0x12f, 0xf, 0xf, true)); }
template <bool WT> struct EpiUp {
    static constexpr bool PERM = WT, AFTER_DRAIN = false;
    bf16_t* ACT; const float* cw; const float* cb;
    DI void operator()(const f32x4 (&acc)[2][2][4][2], const pg8::Unit& u, int wr, int wc, int fr, int fq) const {
#pragma unroll
        for (int ai = 0; ai < 2; ++ai) {
            const int tok0 = 62 * (u.pm * 4 + ai * 2 + wr) - 1;
            u32x2 keep[4];
#pragma unroll
            for (int n = 0; n < 2; ++n) {
                const int j = WT ? u.pn * 128 + wc * 32 + 8 * fq + 4 * n : u.pn * 128 + wc * 32 + 16 * n + 4 * fq;
                const f32x4 wg0 = *(const f32x4*)(cw + j), wg1 = *(const f32x4*)(cw + UPW + j), wg2 = *(const f32x4*)(cw + 2 * UPW + j), bg = *(const f32x4*)(cb + j);
                const f32x4 wv0 = *(const f32x4*)(cw + DFF + j), wv1 = *(const f32x4*)(cw + UPW + DFF + j), wv2 = *(const f32x4*)(cw + 2 * UPW + DFF + j), bv = *(const f32x4*)(cb + DFF + j);
#pragma unroll
                for (int m = 0; m < 4; ++m) {
                    const int local = m * 16 + fr, token = tok0 + local;
                    const f32x4 gc = acc[ai][0][m][n], vc = acc[ai][1][m][n];
                    const f32x4 gpa = acc[ai][0][m > 0 ? m - 1 : 0][n], vpa = acc[ai][1][m > 0 ? m - 1 : 0][n];
                    const f32x4 gna = acc[ai][0][m < 3 ? m + 1 : 3][n], vna = acc[ai][1][m < 3 ? m + 1 : 3][n];
                    f32x4 gp, gn, vp, vn;
#pragma unroll
                    for (int e = 0; e < 4; ++e) {
                        gp[e] = dpp_prev(fr == 15 ? gpa[e] : gc[e]); gn[e] = dpp_next(fr == 0 ? gna[e] : gc[e]);
                        vp[e] = dpp_prev(fr == 15 ? vpa[e] : vc[e]); vn[e] = dpp_next(fr == 0 ? vna[e] : vc[e]);
                    }
                    const int pos = token < NPROMPT ? (token & 255) : ((token - NPROMPT) & 1023), L = token < NPROMPT ? 256 : 1024;
                    const float mp = pos > 0 ? 1.f : 0.f, mn = pos < L - 1 ? 1.f : 0.f;
                    f32x4 g, v;
                    if (__builtin_amdgcn_ballot_w64(mp == 0.f || mn == 0.f) == 0ull) {
                        g = gp * wg0 + gc * wg1 + gn * wg2 + bg; v = vp * wv0 + vc * wv1 + vn * wv2 + bv;
                    } else {
                        g = (gp * mp) * wg0 + gc * wg1 + (gn * mn) * wg2 + bg; v = (vp * mp) * wv0 + vc * wv1 + (vn * mn) * wv2 + bv;
                    }
                    f32x4 a;
#pragma unroll
                    for (int e = 0; e < 4; ++e) a[e] = silu_f(g[e]) * v[e];
                    u32x2 o; o.x = pk_bf16(a.x, a.y); o.y = pk_bf16(a.z, a.w);
                    if (WT) {
                        if (n == 0) keep[m] = o;
                        else if (local >= 1 && local <= 62 && token < NTOK) { u32x4 o4; o4.x = keep[m].x; o4.y = keep[m].y; o4.z = o.x; o4.w = o.y; st16_wt(ACT + (size_t)token * DFF + (j - 4), o4); }
                    } else {
                        if ((m & 1) == 0) keep[m] = o;
                        else {
                            auto rx = __builtin_amdgcn_permlane16_swap(keep[m - 1].x, o.x, false, false); auto ry = __builtin_amdgcn_permlane16_swap(keep[m - 1].y, o.y, false, false);
                            u32x4 o4; o4.x = rx[0]; o4.y = ry[0]; o4.z = rx[1]; o4.w = ry[1];
                            const bool oddq = (fq & 1) != 0; const int loc = oddq ? local : local - 16, tok = tok0 + loc;
                            if (loc >= 1 && loc <= 62 && tok < NTOK) *(u32x4*)(ACT + (size_t)tok * DFF + (oddq ? j - 4 : j)) = o4;
                        }
                    }
                }
            }
        }
    }
};

DI void tr_read8(unsigned a0, unsigned a1, unsigned a2, unsigned a3, unsigned a4, unsigned a5, unsigned a6, unsigned a7,
                 s16x4& r0, s16x4& r1, s16x4& r2, s16x4& r3, s16x4& r4, s16x4& r5, s16x4& r6, s16x4& r7) {
    asm volatile("ds_read_b64_tr_b16 %0, %8\n\tds_read_b64_tr_b16 %1, %9\n\tds_read_b64_tr_b16 %2, %10\n\tds_read_b64_tr_b16 %3, %11\n\t"
                 "ds_read_b64_tr_b16 %4, %12\n\tds_read_b64_tr_b16 %5, %13\n\tds_read_b64_tr_b16 %6, %14\n\tds_read_b64_tr_b16 %7, %15\n\ts_waitcnt lgkmcnt(0)"
                 : "=&v"(r0), "=&v"(r1), "=&v"(r2), "=&v"(r3), "=&v"(r4), "=&v"(r5), "=&v"(r6), "=&v"(r7)
                 : "v"(a0), "v"(a1), "v"(a2), "v"(a3), "v"(a4), "v"(a5), "v"(a6), "v"(a7) : "memory");
}
typedef short v4i16_t __attribute__((ext_vector_type(4)));
DI s16x4 vtr(LAS const unsigned char* p) { return __builtin_bit_cast(s16x4, __builtin_amdgcn_ds_read_tr16_b64_v4i16((LAS v4i16_t*)p)); }
DI float quad_max(float v) {
    auto a = __builtin_amdgcn_permlane16_swap(__float_as_uint(v), __float_as_uint(v), false, false);
    const float t = fmaxf(__uint_as_float(a[0]), __uint_as_float(a[1]));
    auto b = __builtin_amdgcn_permlane32_swap(__float_as_uint(t), __float_as_uint(t), false, false);
    return fmaxf(__uint_as_float(b[0]), __uint_as_float(b[1]));
}
DI float quad_sum(float v) {
    auto a = __builtin_amdgcn_permlane16_swap(__float_as_uint(v), __float_as_uint(v), false, false);
    const float t = __uint_as_float(a[0]) + __uint_as_float(a[1]);
    auto b = __builtin_amdgcn_permlane32_swap(__float_as_uint(t), __float_as_uint(t), false, false);
    return __uint_as_float(b[0]) + __uint_as_float(b[1]);
}
struct AttState { f32x4 o[4]; float m, l; };
struct AttUnit { int tq0, qcol, ktok0, kcol, vcol, nt0, nt1, ocol, slot, kstart, rs0, qb, cpitch; const bf16_t* ck; const bf16_t* cv; float m0, l0; };
template <int MODE>
DI void att_tile(AttState& st, const bf16_t* Kt, const LAS unsigned char* Vt3, const bf16x8 (&qf)[2], const int lr, const int quad, const int dq, const int ws, const float* bt, const int (&bidx)[2][4]) {
    constexpr int NKT = (MODE == 2) ? 2 : 4;
    const int koff = (MODE == 2) ? ws : 0;
    f32x4 s[NKT];
    bf16x8 kf[NKT][2];
#pragma unroll
    for (int kt = 0; kt < NKT; ++kt)
#pragma unroll
        for (int ks = 0; ks < 2; ++ks) kf[kt][ks] = *(const bf16x8*)(Kt + (koff + kt * 16 + lr) * LDP + ks * 32 + quad * 8);
    __builtin_amdgcn_s_setprio(1);
#pragma unroll
    for (int kt = 0; kt < NKT; ++kt) {
        s[kt] = __builtin_amdgcn_mfma_f32_16x16x32_bf16(kf[kt][0], qf[0], (f32x4){0.f, 0.f, 0.f, 0.f}, 0, 0, 0);
        s[kt] = __builtin_amdgcn_mfma_f32_16x16x32_bf16(kf[kt][1], qf[1], s[kt], 0, 0, 0);
    }
    __builtin_amdgcn_s_setprio(0);
    const LAS unsigned char* vrow = Vt3 + (unsigned)(((koff + quad * 4 + (lr >> 2)) * LDP + 4 * (lr & 3)) * 2);
    s16x4 vlo[NKT / 2][4], vhi[NKT / 2][4];
#pragma unroll
    for (int s2 = 0; s2 < NKT / 2; ++s2)
#pragma unroll
        for (int d = 0; d < 4; ++d) { vlo[s2][d] = vtr(vrow + s2 * 32 * LDP * 2 + d * 32); vhi[s2][d] = vtr(vrow + (s2 * 32 + 16) * LDP * 2 + d * 32); }
    if (MODE == 1) {
#pragma unroll
        for (int kt = 0; kt < NKT; ++kt)
#pragma unroll
            for (int e = 0; e < 4; ++e) { int dd = dq - (kt * 16 + quad * 4 + e); dd = dd < 0 ? -dd : dd; s[kt][e] = (dd <= 128) ? s[kt][e] : -INFINITY; }
    }
    if (MODE == 2) {
#pragma unroll
        for (int kt = 0; kt < NKT; ++kt)
#pragma unroll
            for (int e = 0; e < 4; ++e) s[kt][e] += bt[bidx[kt][e]];
    }
    float mx = fmaxf(fmaxf(fmaxf(s[0][0], s[0][1]), fmaxf(s[0][2], s[0][3])), fmaxf(fmaxf(s[1][0], s[1][1]), fmaxf(s[1][2], s[1][3])));
    if (NKT == 4) mx = fmaxf(mx, fmaxf(fmaxf(fmaxf(s[NKT - 2][0], s[NKT - 2][1]), fmaxf(s[NKT - 2][2], s[NKT - 2][3])), fmaxf(fmaxf(s[NKT - 1][0], s[NKT - 1][1]), fmaxf(s[NKT - 1][2], s[NKT - 1][3]))));
    mx = quad_max(mx);
    const float m_new = fmaxf(st.m, mx);
    if (__builtin_amdgcn_ballot_w64(m_new > st.m) != 0ull) {
        const float alpha = __builtin_amdgcn_exp2f(st.m - m_new);
        st.l *= alpha;
        const f32x2 a2 = {alpha, alpha};
#pragma unroll
        for (int d = 0; d < 4; ++d) { f32x2 lo = {st.o[d][0], st.o[d][1]}, hi = {st.o[d][2], st.o[d][3]}; lo *= a2; hi *= a2; st.o[d] = (f32x4){lo.x, lo.y, hi.x, hi.y}; }
        st.m = m_new;
    }
    const f32x2 mm = {m_new, m_new};
    f32x2 ps2 = {0.f, 0.f};
#pragma unroll
    for (int kt = 0; kt < NKT; ++kt) {
        f32x2 lo = {s[kt][0], s[kt][1]}, hi = {s[kt][2], s[kt][3]}; lo -= mm; hi -= mm;
        s[kt][0] = __builtin_amdgcn_exp2f(lo.x); s[kt][1] = __builtin_amdgcn_exp2f(lo.y); s[kt][2] = __builtin_amdgcn_exp2f(hi.x); s[kt][3] = __builtin_amdgcn_exp2f(hi.y);
        ps2 += (f32x2){s[kt][0], s[kt][1]}; ps2 += (f32x2){s[kt][2], s[kt][3]};
    }
    st.l += ps2.x + ps2.y;
#pragma unroll
    for (int s2 = 0; s2 < NKT / 2; ++s2) {
        u32x4 pbu; pbu.x = pk_bf16(s[2 * s2][0], s[2 * s2][1]); pbu.y = pk_bf16(s[2 * s2][2], s[2 * s2][3]); pbu.z = pk_bf16(s[2 * s2 + 1][0], s[2 * s2 + 1][1]); pbu.w = pk_bf16(s[2 * s2 + 1][2], s[2 * s2 + 1][3]);
        const bf16x8 pb = __builtin_bit_cast(bf16x8, pbu);
        __builtin_amdgcn_s_setprio(1);
#pragma unroll
        for (int d = 0; d < 4; ++d) st.o[d] = __builtin_amdgcn_mfma_f32_16x16x32_bf16(__builtin_shufflevector(vlo[s2][d], vhi[s2][d], 0, 1, 2, 3, 4, 5, 6, 7), pb, st.o[d], 0, 0, 0);
        __builtin_amdgcn_s_setprio(0);
    }
}
template <int TYPE>
DI void attn_unit(const P& p, const AttUnit& au, unsigned char* lds, const int tid, const bool reuse_kv = false) {
    bf16_t* Kl = (bf16_t*)lds; bf16_t* Vl = Kl + 256 * LDP; float* rpbl = (float*)(lds + 2 * 256 * LDP * 2);
    const LAS unsigned char* Vl3 = (const LAS unsigned char*)lds + 256 * LDP * 2;
    const int w = tid >> 6, lane = tid & 63, lr = lane & 15, quad = lane >> 4;
    const bf16_t* Z = (const bf16_t*)(p.ws + OFF_Z);
    const int total = au.nt0 + au.nt1, nchunks = (total + 3) >> 2;
    const int qidx = w * 16 + lr;
    if (!reuse_kv) __syncthreads();
    int bidx[2][4] = {{0, 0, 0, 0}, {0, 0, 0, 0}}; int ws = 0, rsg = 0;
    if (TYPE == 2) {
        const int hh = au.ocol >> 6;
        if (tid < 480) { const int dr = tid >> 5, c = tid & 31; rpbl[tid] = c < 31 ? p.in[I_RPB][hh * 465 + dr * 31 + c] * 1.4426950408889634f : -INFINITY; }
        const int wq = w & 3; ws = wq == 0 ? 0 : (wq == 1 ? 8 : (wq == 2 ? 24 : 32));
        const int qc = qidx & 63; int cs = qc - 8; cs = cs < 0 ? 0 : (cs > 48 ? 48 : cs);
#pragma unroll
        for (int kt = 0; kt < 2; ++kt)
#pragma unroll
            for (int e = 0; e < 4; ++e) { const int kc = ws + kt * 16 + quad * 4 + e; int dc = kc - qc; dc = dc < -15 ? -15 : (dc > 15 ? 15 : dc); bidx[kt][e] = ((kc >= cs) && (kc < cs + 16)) ? dc + 15 : 31; }
        rsg = 2 * au.qb + (w >> 2) - 4; rsg = rsg < 0 ? 0 : (rsg > 8 ? 8 : rsg);
    }
    bf16x8 qf[2];
    {
        const bf16_t* qp = Z + (size_t)(au.tq0 + qidx) * INW + au.qcol + quad * 8;
        qf[0] = *(const bf16x8*)qp; qf[1] = *(const bf16x8*)(qp + 32);
    }
    AttState st;
#pragma unroll
    for (int d = 0; d < 4; ++d) st.o[d] = (f32x4){0.f, 0.f, 0.f, 0.f};
    st.m = au.m0; st.l = (quad == 0) ? au.l0 : 0.f;
    u32x4 rk[4], rv[4];
#define ATT_PREFETCH(c) do { _Pragma("unroll") for (int i_ = 0; i_ < 4; ++i_) { const int pc_ = tid + NTHR * i_, row_ = pc_ >> 3, c16_ = (pc_ & 7) * 8; const int ti_ = 4 * (c) + (row_ >> 6); \
        if (ti_ < total) { const bf16_t *kp_, *vp_; \
            if (ti_ < au.nt0) { const size_t ro_ = (size_t)(au.ktok0 + ti_ * 64 + (row_ & 63)) * INW + c16_; kp_ = Z + ro_ + au.kcol; vp_ = Z + ro_ + au.vcol; } \
            else { const size_t ro_ = (size_t)((ti_ - au.nt0) * 64 + (row_ & 63)) * au.cpitch + c16_; kp_ = au.ck + ro_; vp_ = au.cv + ro_; } \
            rk[i_] = *(const u32x4*)kp_; rv[i_] = *(const u32x4*)vp_; } } } while (0)
    if (!reuse_kv) ATT_PREFETCH(0);
    for (int c = 0; c < nchunks; ++c) {
        if (!(reuse_kv && c == 0)) {
        if (c > 0) __syncthreads();
#pragma unroll
        for (int i = 0; i < 4; ++i) { const int pc = tid + NTHR * i, lo_ = (pc >> 3) * LDP + (pc & 7) * 8; *(u32x4*)(Kl + lo_) = rk[i]; *(u32x4*)(Vl + lo_) = rv[i]; }
        __syncthreads();
        }
        if (c + 1 < nchunks) ATT_PREFETCH(c + 1);
        for (int tt = 0; tt < 4; ++tt) {
            const int t = 4 * c + tt;
            if (t >= total) break;
            const bf16_t* Kt = Kl + tt * 64 * LDP; const LAS unsigned char* Vt3 = Vl3 + tt * 64 * LDP * 2;
            if (TYPE == 2 && t < au.nt0) {
                const int kr = au.rs0 + t; if (kr < rsg || kr >= rsg + 8) continue;
                const int drow = kr - (2 * au.qb + (w >> 2)) + 7;
                att_tile<2>(st, Kt, Vt3, qf, lr, quad, 0, ws, rpbl + drow * 32, bidx);
            } else if (TYPE == 3 && t < au.nt0) {
                const int qw = au.qb * 128 + w * 16, k0 = au.kstart + t * 64;
                if (k0 + 63 < qw - 128 || k0 > qw + 15 + 128) continue;
                if (k0 < qw + 15 - 128 || k0 + 63 > qw + 128) att_tile<1>(st, Kt, Vt3, qf, lr, quad, au.qb * 128 + qidx - k0, 0, nullptr, bidx);
                else att_tile<0>(st, Kt, Vt3, qf, lr, quad, 0, 0, nullptr, bidx);
            } else att_tile<0>(st, Kt, Vt3, qf, lr, quad, 0, 0, nullptr, bidx);
        }
    }
#undef ATT_PREFETCH
    bf16_t* O = (bf16_t*)(p.ws + OFF_O); float* SS = (float*)(p.ws + OFF_SS);
    const float il = 1.f / quad_sum(st.l);
    const int tok = au.tq0 + qidx;
    float ss = 0.f;
#pragma unroll
    for (int d = 0; d < 4; ++d) {
        const f32x4 v = st.o[d] * il; ss += dot4(v);
        u32x2 ov; ov.x = pk_bf16(v.x, v.y); ov.y = pk_bf16(v.z, v.w);
        *(u32x2*)(O + (size_t)tok * DM + au.ocol + d * 16 + quad * 4) = ov;
    }
    ss = quad_sum(ss);
    if (quad == 0) SS[(size_t)tok * 16 + au.slot] = ss;
}
DI void attn_phase(const P& p, int bid, int nb, unsigned char* lds, int tid) {
    for (int u = bid; u < 768; u += nb) {
        int type, b, h, qb;
        if (u < 128) { type = 2; b = u >> 6; h = (u >> 3) & 7; qb = u & 7; }
        else if (u < 256) { type = 3; const int v = u - 128; b = v >> 6; h = (v >> 3) & 7; qb = v & 7; }
        else { const int pr = (u - 256) & 255; qb = (u - 256) >> 8; type = pr >> 7; b = (pr >> 3) & 15; h = pr & 7; }
        const bool reuse = (nb == 256) && (u >= 512);
        AttUnit au; au.qb = qb; au.nt1 = 0; au.kstart = 0; au.rs0 = 0; au.ck = nullptr; au.cv = nullptr; au.cpitch = 0; au.m0 = -1e30f; au.l0 = 0.f;
        if (type == 0) { au.tq0 = b * 256 + qb * 128; au.qcol = h * 64; au.ktok0 = b * 256; au.kcol = 512 + h * 64; au.vcol = 1024 + h * 64; au.nt0 = 4; au.ocol = h * 64; au.slot = h; attn_unit<0>(p, au, lds, tid, reuse); }
        else if (type == 1) { au.tq0 = b * 256 + qb * 128; au.qcol = 1536 + h * 64; au.ktok0 = b * 256; au.kcol = 2048 + (h >> 2) * 64; au.vcol = 2176 + (h >> 2) * 64; au.nt0 = 4; au.ocol = 512 + h * 64; au.slot = 8 + h;
            au.m0 = p.in[I_SINK][h] * 1.4426950408889634f; au.l0 = 1.f; attn_unit<1>(p, au, lds, tid, reuse); }
        else if (type == 2) { au.tq0 = NPROMPT + b * 1024 + qb * 128; au.qcol = h * 64;
            int rs0 = 2 * qb - 4; rs0 = rs0 < 0 ? 0 : (rs0 > 8 ? 8 : rs0); int rs1 = 2 * qb + 1 - 4; rs1 = rs1 < 0 ? 0 : (rs1 > 8 ? 8 : rs1); au.rs0 = rs0;
            au.ktok0 = NPROMPT + b * 1024 + rs0 * 64; au.kcol = 512 + h * 64; au.vcol = 1024 + h * 64; au.nt0 = rs1 + 8 - rs0; au.ocol = h * 64; au.slot = h;
            au.nt1 = 4; au.ck = (const bf16_t*)(p.ws + OFF_CAK) + (size_t)b * 256 * 512 + h * 64; au.cv = (const bf16_t*)(p.ws + OFF_CAV) + (size_t)b * 256 * 512 + h * 64; au.cpitch = 512; attn_unit<2>(p, au, lds, tid); }
        else { au.tq0 = NPROMPT + b * 1024 + qb * 128; au.qcol = 1536 + h * 64; int kstart = qb * 128 - 128; if (kstart < 0) kstart = 0; int kend = qb * 128 + 256; if (kend > 1024) kend = 1024; au.kstart = kstart;
            au.ktok0 = NPROMPT + b * 1024 + kstart; au.kcol = 2048 + (h >> 2) * 64; au.vcol = 2176 + (h >> 2) * 64; au.nt0 = (kend - kstart) >> 6; au.ocol = 512 + h * 64; au.slot = 8 + h;
            au.nt1 = 4; au.ck = (const bf16_t*)(p.ws + OFF_CBK) + (size_t)b * 256 * 128 + (h >> 2) * 64; au.cv = (const bf16_t*)(p.ws + OFF_CBV) + (size_t)b * 256 * 128 + (h >> 2) * 64; au.cpitch = 128;
            au.m0 = p.in[I_SINK][h] * 1.4426950408889634f; au.l0 = 1.f; attn_unit<3>(p, au, lds, tid); }
    }
}

struct UpOrder {
    int c, tail;
    DI bool next(int i, pg8::Unit& u) const {
        if (tail) { if (i > 0 || c >= 38) return false; u.pm = c >> 1; u.pn = (c & 1) ? 21 : 10; return true; }
        if (i >= 2) return false;
        const int s = i * 256 + (c & 7) * 32 + (c >> 3);
        if (s < 500) { const int g = s / 160, w = s % 160, gsz = (g < 3) ? 8 : 1; u.pm = 8 * g + (w % gsz); const int pi = w / gsz; u.pn = pi < 10 ? pi : pi + 1; }
        else { const int e = s - 500; u.pm = 19 + (e >> 1); u.pn = (e & 1) ? 21 : 10; }
        return true;
    }
    DI void a_ready(const pg8::Unit&) const {}
    DI void done(const pg8::Unit&) const {}
};
constexpr int CNT_BASE = 4096;
__global__ void __launch_bounds__(NTHR, 2) mega(P p) {
    extern __shared__ __attribute__((aligned(16))) unsigned char lds[];
    const int tid = threadIdx.x, bid = blockIdx.x, nb = gridDim.x, lane = tid & 63, wv = tid >> 6;
    volatile LAS unsigned* bst = (volatile LAS unsigned*)((LAS unsigned char*)lds + LDS_MAIN);
    if (tid < 16) bst[tid] = 0u;
    __syncthreads();
    unsigned* ctl = (unsigned*)(p.ws + OFF_BAR);
    XcdBarrier bar = xcd_barrier_post(ctl, bst);
    unsigned* cntA = ctl + CNT_BASE;
    unsigned* cnt4 = ctl + CNT_BASE + 64;
    unsigned* cnt7 = ctl + CNT_BASE + 64 + 24 * 64;
    LAS unsigned char* lds3 = (LAS unsigned char*)lds;
    float* scr = (float*)lds;
    bf16_t* wsH = (bf16_t*)(p.ws + OFF_H);
    const bool std_grid = (nb == 256);
    p0_phase(p, bid, nb, scr, tid, cntA);
    p1_rows<3>(p, bid * NWAVE + wv, nb * NWAVE, NTOK, lane, cntA, tid);
    xcd_barrier(bar);
    {
        pg8::Gemm g{wsH, (const bf16_t*)(p.ws + OFF_WIN), 1024, 1024, 1 << 30, 0, 0, nullptr, 0}; pg8::StaticOrder S; S.init(NTOK, INW, nb, bid);
        EpiInproj E{(bf16_t*)(p.ws + OFF_Z), p.out};
        pg8::gemm_phase<EpiInproj, pg8::StaticOrder, true, true>(lds3, g, S, E);
        __syncthreads();
        const int h0 = std_grid ? 216 : 0, nh = nb - h0;
        if (bid >= h0) tr_range(p, T_IN + (bid - h0), T_IN + T_OUT + 200, nh, scr, tid);
    }
    xcd_barrier(bar);
    attn_phase(p, bid, nb, lds, tid);
    xcd_barrier(bar);
    {
        pg8::Gemm g{(const bf16_t*)(p.ws + OFF_O), (const bf16_t*)(p.ws + OFF_WOUT), 512, 1024, 4, 1024, 0, nullptr, 0}; pg8::StaticOrder S; S.init(NTOK, 2048, nb, bid);
        EpiF32 E{(bf16_t*)(p.ws + OFF_MIX)};
        pg8::gemm_phase<EpiF32, pg8::StaticOrder, true, true>(lds3, g, S, E);
        __syncthreads();
        const int h0 = std_grid ? 192 : 0, nh = nb - h0;
        if (bid >= h0) tr_range(p, T_IN + T_OUT + 200 + (bid - h0), T_IN + T_OUT + T_UP + T_DOWN, nh, scr, tid);
        pg8::Unit u;
        if (nb >= 192) {
            if (S.next(0, u)) { publish_inc_wt(cnt4 + 64 * u.pm, tid); const int r0 = u.pm * 256 + u.pn * 32; p5_rows<4>(p, r0 + wv, NWAVE, r0 + 32, lane, cnt4 + 64 * u.pm, tid); }
        } else { xcd_barrier(bar); p5_rows<3>(p, bid * NWAVE + wv, nb * NWAVE, NTOK, lane); }
    }
    xcd_barrier(bar);
    unsigned* tflag = ctl + CNT_BASE + 64 + 48 * 64;
    {
        pg8::Gemm g{wsH, (const bf16_t*)(p.ws + OFF_WUP), 1024, 1024, 1 << 30, 0, 1, nullptr, 0}; UpOrder S{bid, 0};
        EpiUp<false> E{(bf16_t*)(p.ws + OFF_ACT), p.in[I_CONVW], p.in[I_CONVB]};
        pg8::gemm_phase<EpiUp<false>, UpOrder, true, true>(lds3, g, S, E);
    }
    xcd_barrier(bar);
    if (bid < 38) {
        pg8::Gemm g{wsH, (const bf16_t*)(p.ws + OFF_WUP), 1024, 1024, 1 << 30, 0, 1, nullptr, 0}; UpOrder S{bid, 1};
        EpiUp<true> E{(bf16_t*)(p.ws + OFF_ACT), p.in[I_CONVW], p.in[I_CONVB]};
        pg8::gemm_phase<EpiUp<true>, UpOrder, true, true>(lds3, g, S, E);
        publish_inc_wt(tflag + ((bid >> 1) * 2 + (bid & 1)) * 64, tid);
    } else {
        pg8::Gemm g{(const bf16_t*)(p.ws + OFF_ACT), (const bf16_t*)(p.ws + OFF_WDOWN), 1408, 2816, 4, 2816, 0, tflag, 18}; pg8::StaticOrder S; S.init(NTOK, 2048, nb, bid - 38);
        EpiF32 E{(bf16_t*)(p.ws + OFF_MIX)};
        pg8::gemm_phase<EpiF32, pg8::StaticOrder, true, true>(lds3, g, S, E);
        pg8::Unit u;
        if (S.next(0, u)) { publish_inc_wt(cnt7 + 64 * u.pm, tid); const int r0 = u.pm * 256 + u.pn * 32; p8_rows<4>(p, r0 + wv, NWAVE, r0 + 32, lane, cnt7 + 64 * u.pm, tid); }
    }
}

extern "C" void kernel_launch(void* const* d_in, const int* in_sizes, int n_in, void* d_out, int out_size, void* d_ws, size_t ws_size, hipStream_t stream) {
    static int grid_blocks = 0;
    if (!grid_blocks) {
        int dev = 0, cus = 0, per_cu = 0;
        (void)hipGetDevice(&dev);
        (void)hipDeviceGetAttribute(&cus, hipDeviceAttributeMultiprocessorCount, dev);
        (void)hipFuncSetAttribute((const void*)mega, hipFuncAttributeMaxDynamicSharedMemorySize, LDS_BYTES);
        (void)hipOccupancyMaxActiveBlocksPerMultiprocessor(&per_cu, (const void*)mega, NTHR, LDS_BYTES);
        if (per_cu < 1) { fprintf(stderr, "kernel_launch: occupancy query reports %d blocks per CU\n", per_cu); per_cu = 1; }
        grid_blocks = cus;
        if (cus != 256) fprintf(stderr, "kernel_launch: this kernel's unit orders are built for 256 CUs (MI355X); found %d\n", cus);
        if (n_in != 24 || ws_size < WS_END) fprintf(stderr, "kernel_launch: unexpected n_in %d / ws_size %zu (need %zu)\n", n_in, ws_size, (size_t)WS_END);
    }
    P p{};
    for (int i = 0; i < 24; ++i) p.in[i] = (const float*)d_in[i];
    p.out = (float*)d_out; p.ws = (unsigned char*)d_ws;
    (void)hipMemsetAsync((unsigned char*)d_ws + OFF_BAR, 0, 65536, stream);
    void* args[] = {&p};
    hipError_t e = hipLaunchCooperativeKernel((const void*)mega, dim3(grid_blocks), dim3(NTHR), args, LDS_BYTES, stream);
    if (e != hipSuccess) fprintf(stderr, "cooperative launch failed: %s (grid %d)\n", hipGetErrorString(e), grid_blocks);
}
```

```cpp
#include <hip/hip_runtime.h>
#include <hip/hip_cooperative_groups.h>
#include <cstdio>
#include <cstdint>
namespace cg = cooperative_groups;


namespace pg8 {
#define PG8_LAS __attribute__((address_space(3)))
typedef unsigned short bf16_t;
typedef short bf16x8 __attribute__((ext_vector_type(8)));
typedef float f32x4 __attribute__((ext_vector_type(4)));
typedef unsigned u32x4 __attribute__((ext_vector_type(4)));
constexpr int BM = 256, BK = 64, HALF = 128, HTB = HALF * BK * 2  , STAGE_BYTES = 8 * HTB, NXCD = 8, WGM = 8;

__host__ __device__ __forceinline__ int lds_byte(int r, int c) { const int st = (r >> 4) * 2 + (c >> 5), rr = r & 15, cc = c & 31, ob = rr * 64 + cc * 2; return st * 1024 + (ob ^ (((ob >> 9) & 1) << 5)); }
__host__ __device__ __forceinline__ void stage_rc(int b, int& R, int& C) { const int st = b / 1024, sb = b % 1024, swz = sb ^ (((sb >> 9) & 1) << 5); R = (st >> 1) * 16 + swz / 64; C = (st & 1) * 32 + (swz % 64) / 2; }
__host__ __device__ __forceinline__ int perm32(int rho) { const int n = rho >> 4, i = rho & 15; return 8 * (i >> 2) + 4 * n + (i & 3); }

struct Unit { int pm, pn; };
struct Gemm { const bf16_t* A; const bf16_t* Bt; int K, lda, nsplit, a_coloff, seg; const unsigned* kflags; int kwait_t; };

struct StaticOrder {
    int nM, nN, nwg, G, c;
    __host__ __device__ void init(int M, int N, int G_, int c_) { nM = M / BM; nN = N / BM; nwg = nM * nN; G = G_; c = c_; }
    __host__ __device__ bool next(int i, Unit& u) const {
        const long L = (long)i * G + c; if (L >= nwg) return false;
        int wgid = (int)L; { const int q = nwg / NXCD, r = nwg % NXCD, xcd = wgid % NXCD, off = wgid / NXCD; wgid = (xcd < r ? xcd * (q + 1) : r * (q + 1) + (xcd - r) * q) + off; }
        const int nig = WGM * nN, gid = wgid / nig, fm = gid * WGM, gsz = (nM - fm) < WGM ? (nM - fm) : WGM;
        u.pm = fm + ((wgid % nig) % gsz); u.pn = (wgid % nig) / gsz; return true;
    }
    __device__ __forceinline__ void a_ready(const Unit&) const {}
    __device__ __forceinline__ void done(const Unit&) const {}
};

template <class Epi, class Sched, bool ALIGN_EPI = false, bool SP2 = false>
__device__ __forceinline__ void gemm_phase(PG8_LAS unsigned char* lds, const Gemm g, const Sched& S, const Epi& E) {
    int tid_ = threadIdx.x; asm volatile("" : "+v"(tid_));
    const int tid = tid_, wid = __builtin_amdgcn_readfirstlane(tid >> 6), lane = tid & 63, wr = wid >> 2, wc = wid & 3, fr = lane & 15, fq = lane >> 4;
    const int K = g.K, nt = K / BK;
    unsigned voffA[2], voffB[2];
#pragma unroll
    for (int i = 0; i < 2; ++i) { int R, C; stage_rc(tid * 16 + i * 8192, R, C); const int Rb = Epi::PERM ? ((R & ~31) + perm32(R & 31)) : R;
        const int Ra = g.seg ? 62 * (R >> 6) + (R & 63) : R; voffA[i] = (unsigned)(Ra * g.lda + C) * 2u; voffB[i] = (unsigned)(Rb * K + C) * 2u; }
    const size_t kstep = (size_t)(BK * 2);
    const size_t hstep = (size_t)HALF * K * 2;
    const size_t tstep = 2 * hstep;
    const size_t ahs = (size_t)(g.seg ? 124 : 128) * g.lda * 2, ats = 2 * ahs;
#define PG8_APTR(u) ((const char*)g.A + (size_t)(u).pm * ats - (g.seg ? (size_t)g.lda * 2 : 0) + ((u).pn >= g.nsplit ? (size_t)g.a_coloff : 0))
    const unsigned ldsw = (unsigned)wid * 1024u;
    const int aoff = lds_byte(wr * 64 + fr, fq * 8), boff = lds_byte(wc * 32 + fr, fq * 8);
#define PG8_SA(b, h) (((b) * 2 + (h)) * HTB)
#define PG8_SB(b, h) ((4 + (b) * 2 + (h)) * HTB)
#define PG8_STAGE(bufoff, gbase, voff) do { _Pragma("unroll") for (int _i = 0; _i < 2; ++_i) \
        __builtin_amdgcn_global_load_lds((const unsigned*)((const char*)(gbase) + (voff)[_i]), (PG8_LAS unsigned*)(lds + (bufoff) + ldsw + _i * 8192), 16, 0, 0); } while (0)
#define PG8_LDA(dst, b, h) do { _Pragma("unroll") for (int m = 0; m < 4; ++m) _Pragma("unroll") for (int k = 0; k < 2; ++k) dst[m][k] = *(const PG8_LAS bf16x8*)(lds + PG8_SA(b, h) + aoff + m * 2048 + k * 1024); } while (0)
#define PG8_LDB(dst, b, h) do { _Pragma("unroll") for (int n = 0; n < 2; ++n) _Pragma("unroll") for (int k = 0; k < 2; ++k) dst[n][k] = *(const PG8_LAS bf16x8*)(lds + PG8_SB(b, h) + boff + n * 2048 + k * 1024); } while (0)
#define PG8_MMA(ai, bj, At, Bt) do { __builtin_amdgcn_s_setprio(1); _Pragma("unroll") for (int m = 0; m < 4; ++m) _Pragma("unroll") for (int n = 0; n < 2; ++n) _Pragma("unroll") for (int k = 0; k < 2; ++k) \
        acc[ai][bj][m][n] = __builtin_amdgcn_mfma_f32_16x16x32_bf16(Bt[n][k], At[m][k], acc[ai][bj][m][n], 0, 0, 0); __builtin_amdgcn_s_setprio(0); } while (0)
#define PG8_WAIT_V(n) asm volatile("s_waitcnt vmcnt(" #n ")" ::: "memory")
#define PG8_WAIT_L(n) asm volatile("s_waitcnt lgkmcnt(" #n ")" ::: "memory")
#define PG8_BAR __builtin_amdgcn_s_barrier()
#define PG8_SCHED __builtin_amdgcn_sched_barrier(0)
    Unit cur, nxt; int ui = 0;
    if (!S.next(0, cur)) return;
    f32x4 acc[2][2][4][2];
#pragma unroll
    for (int a = 0; a < 2; ++a)
#pragma unroll
        for (int b = 0; b < 2; ++b)
#pragma unroll
            for (int m = 0; m < 4; ++m)
#pragma unroll
                for (int n = 0; n < 2; ++n) acc[a][b][m][n] = (f32x4){0.f, 0.f, 0.f, 0.f};
    bf16x8 At[4][2], B0[2][2], B1[2][2];
    const char* cA = PG8_APTR(cur); const char* cB = (const char*)g.Bt + (size_t)cur.pn * tstep;
    S.a_ready(cur);
    if constexpr (SP2) {
        PG8_STAGE(PG8_SB(0, 0), cB, voffB); PG8_STAGE(PG8_SB(0, 1), cB + hstep, voffB); PG8_STAGE(PG8_SA(0, 0), cA, voffA); PG8_STAGE(PG8_SA(0, 1), cA + ahs, voffA);
        if (wr == 1) PG8_BAR;
        PG8_WAIT_V(2); PG8_BAR;
        PG8_STAGE(PG8_SB(1, 0), cB + kstep, voffB); PG8_STAGE(PG8_SA(1, 0), cA + kstep, voffA); PG8_STAGE(PG8_SB(1, 1), cB + hstep + kstep, voffB);
        PG8_WAIT_V(6); PG8_BAR;
    } else {
        PG8_STAGE(PG8_SB(0, 0), cB, voffB); PG8_STAGE(PG8_SA(0, 0), cA, voffA); PG8_STAGE(PG8_SB(0, 1), cB + hstep, voffB); PG8_STAGE(PG8_SA(0, 1), cA + ahs, voffA);
        if (wr == 1) PG8_BAR;
        PG8_WAIT_V(4); PG8_BAR;
        PG8_STAGE(PG8_SB(1, 0), cB + kstep, voffB); PG8_STAGE(PG8_SA(1, 0), cA + kstep, voffA); PG8_STAGE(PG8_SB(1, 1), cB + hstep + kstep, voffB);
        PG8_WAIT_V(6); PG8_BAR;
    }
    for (;;) {
        const bool has_next = S.next(ui + 1, nxt);
        const char* nA = has_next ? PG8_APTR(nxt) : cA; const char* nB = has_next ? (const char*)g.Bt + (size_t)nxt.pn * tstep : cB;
        for (int t = 0; t < nt; t += 2) {
            if (g.kflags && t == g.kwait_t) {
                const int pd_ = cur.pm, ks_ = cur.pn >> 2, p0_ = (256 * pd_) / 248, p1_ = (256 * pd_ + 255) / 248;
                for (int pp_ = p0_; pp_ <= p1_; ++pp_) if (pp_ < 19) { const unsigned* f_ = g.kflags + (pp_ * 2 + ks_) * 64; unsigned sp_ = 0;
                    while (__hip_atomic_load(f_, __ATOMIC_RELAXED, __HIP_MEMORY_SCOPE_AGENT) == 0u) { __builtin_amdgcn_s_sleep(2); if (++sp_ > (1u << 22)) break; } }
                __builtin_amdgcn_fence(__ATOMIC_ACQUIRE, "agent");
            }
            const bool last = (t == nt - 2);
            const char* a1 = cA + (size_t)(t + 1) * kstep;
            const char* a2 = last ? nA : cA + (size_t)(t + 2) * kstep; const char* b2 = last ? nB : cB + (size_t)(t + 2) * kstep;
            const char* a3 = a2 + kstep; const char* b3 = b2 + kstep;
            if (last && has_next) S.a_ready(nxt);
            if constexpr (SP2) {
            PG8_LDB(B0, 0, 0); PG8_LDB(B1, 0, 1); PG8_SCHED; PG8_LDA(At, 0, 0); PG8_STAGE(PG8_SA(1, 1), a1 + ahs, voffA);
            PG8_WAIT_V(8); PG8_WAIT_L(0); PG8_BAR; PG8_MMA(0, 0, At, B0); PG8_MMA(0, 1, At, B1); PG8_BAR; PG8_SCHED;
            PG8_LDA(At, 0, 1); PG8_STAGE(PG8_SB(0, 0), b2, voffB); PG8_STAGE(PG8_SB(0, 1), b2 + hstep, voffB); PG8_STAGE(PG8_SA(0, 0), a2, voffA);
            PG8_WAIT_V(8); PG8_WAIT_L(0); PG8_BAR; PG8_MMA(1, 0, At, B0); PG8_MMA(1, 1, At, B1); PG8_BAR; PG8_SCHED;
            PG8_LDB(B0, 1, 0); PG8_LDB(B1, 1, 1); PG8_SCHED; PG8_LDA(At, 1, 0); PG8_STAGE(PG8_SA(0, 1), a2 + ahs, voffA);
            PG8_WAIT_V(8); PG8_WAIT_L(0); PG8_BAR; PG8_MMA(0, 0, At, B0); PG8_MMA(0, 1, At, B1); PG8_BAR; PG8_SCHED;
            PG8_LDA(At, 1, 1); PG8_STAGE(PG8_SB(1, 0), b3, voffB); PG8_STAGE(PG8_SB(1, 1), b3 + hstep, voffB); PG8_STAGE(PG8_SA(1, 0), a3, voffA);
            PG8_WAIT_V(8); PG8_WAIT_L(0); PG8_BAR; PG8_MMA(1, 0, At, B0); PG8_MMA(1, 1, At, B1); PG8_BAR; PG8_SCHED;
            } else {
            PG8_LDB(B0, 0, 0); PG8_SCHED; PG8_LDA(At, 0, 0); PG8_STAGE(PG8_SA(1, 1), a1 + ahs, voffA);
            PG8_WAIT_L(8); PG8_BAR; PG8_WAIT_L(0); PG8_MMA(0, 0, At, B0); PG8_BAR; PG8_SCHED;
            PG8_LDB(B1, 0, 1); PG8_STAGE(PG8_SB(0, 0), b2, voffB);
            PG8_BAR; PG8_WAIT_L(0); PG8_MMA(0, 1, At, B1); PG8_BAR;
            PG8_LDA(At, 0, 1); PG8_STAGE(PG8_SA(0, 0), a2, voffA);
            PG8_BAR; PG8_WAIT_L(0); PG8_MMA(1, 0, At, B0); PG8_BAR; PG8_SCHED;
            PG8_STAGE(PG8_SB(0, 1), b2 + hstep, voffB);
            PG8_WAIT_V(6); PG8_BAR; PG8_MMA(1, 1, At, B1); PG8_BAR;
            PG8_LDB(B0, 1, 0); PG8_SCHED; PG8_LDA(At, 1, 0); PG8_STAGE(PG8_SA(0, 1), a2 + ahs, voffA);
            PG8_WAIT_L(8); PG8_BAR; PG8_WAIT_L(0); PG8_MMA(0, 0, At, B0); PG8_BAR; PG8_SCHED;
            PG8_LDB(B1, 1, 1); PG8_STAGE(PG8_SB(1, 0), b3, voffB);
            PG8_BAR; PG8_WAIT_L(0); PG8_MMA(0, 1, At, B1); PG8_BAR;
            PG8_LDA(At, 1, 1); PG8_STAGE(PG8_SA(1, 0), a3, voffA);
            PG8_BAR; PG8_WAIT_L(0); PG8_MMA(1, 0, At, B0); PG8_BAR; PG8_SCHED;
            PG8_STAGE(PG8_SB(1, 1), b3 + hstep, voffB);
            PG8_WAIT_V(6); PG8_BAR; PG8_MMA(1, 1, At, B1); PG8_BAR;
            }
        }
        if constexpr (ALIGN_EPI) { if (wr == 0) PG8_BAR; }
        if constexpr (!Epi::AFTER_DRAIN) { E(acc, cur, wr, wc, fr, fq); S.done(cur); }
        if (!has_next) break;
#pragma unroll
        for (int a = 0; a < 2; ++a)
#pragma unroll
            for (int b = 0; b < 2; ++b)
#pragma unroll
                for (int m = 0; m < 4; ++m)
#pragma unroll
                    for (int n = 0; n < 2; ++n) acc[a][b][m][n] = (f32x4){0.f, 0.f, 0.f, 0.f};
        cur = nxt; cA = nA; cB = nB; ++ui;
        if constexpr (ALIGN_EPI) { if (wr == 1) PG8_BAR; }
    }
    PG8_WAIT_V(0);
    if constexpr (!ALIGN_EPI) { if (wr == 0) PG8_BAR; }
    PG8_BAR;
    if constexpr (Epi::AFTER_DRAIN) { E.fused(acc, cur, wr, wc, fr, fq, lds, wid, lane); S.done(cur); }
#undef PG8_APTR
#undef PG8_SA
#undef PG8_SB
#undef PG8_STAGE
#undef PG8_LDA
#undef PG8_LDB
#undef PG8_MMA
#undef PG8_WAIT_V
#undef PG8_WAIT_L
#undef PG8_BAR
#undef PG8_SCHED
}
}

#define DI __device__ __forceinline__
#define LAS __attribute__((address_space(3)))
typedef unsigned short bf16_t;
typedef short bf16x8 __attribute__((ext_vector_type(8)));
typedef short s16x4 __attribute__((ext_vector_type(4)));
typedef float f32x4 __attribute__((ext_vector_type(4)));
typedef float f32x2 __attribute__((ext_vector_type(2)));
typedef unsigned u32x4 __attribute__((ext_vector_type(4)));
typedef unsigned u32x2 __attribute__((ext_vector_type(2)));
typedef __bf16 bf2_t __attribute__((ext_vector_type(2)));

constexpr int NTOK = 6144, NPROMPT = 4096, DM = 1024, INW = 2304, DFF = 2816, UPW = 5632;
constexpr int NTHR = 512, NWAVE = 8;
constexpr float EPS = 1e-6f;

constexpr size_t OFF_BAR = 0;
constexpr size_t OFF_MOD = 65536;
constexpr size_t OFF_WIN = 1u << 20;
constexpr size_t OFF_WOUT = OFF_WIN + (size_t)2304 * 1024 * 2;
constexpr size_t OFF_WUP = OFF_WOUT + (size_t)1024 * 1024 * 2;
constexpr size_t OFF_WDOWN = OFF_WUP + (size_t)5632 * 1024 * 2;
constexpr size_t OFF_CAK = OFF_WDOWN + (size_t)1024 * 2816 * 2;
constexpr size_t OFF_CAV = OFF_CAK + (size_t)2 * 256 * 512 * 2;
constexpr size_t OFF_CBK = OFF_CAV + (size_t)2 * 256 * 512 * 2;
constexpr size_t OFF_CBV = OFF_CBK + (size_t)2 * 256 * 128 * 2;
constexpr size_t OFF_H = OFF_CBV + (size_t)2 * 256 * 128 * 2;
constexpr size_t OFF_Z = OFF_H + (size_t)NTOK * 1024 * 2;
constexpr size_t OFF_O = OFF_Z + (size_t)NTOK * 2304 * 2;
constexpr size_t OFF_SS = OFF_O + (size_t)NTOK * 1024 * 2;
constexpr size_t OFF_MIX = OFF_SS + (size_t)NTOK * 16 * 4;
constexpr size_t OFF_ACT = OFF_MIX + (size_t)2 * NTOK * 1024 * 4;
constexpr size_t WS_END = OFF_ACT + (size_t)NTOK * 2816 * 2;

constexpr size_t OUT_Y = 0, OUT_AK = (size_t)NTOK * 1024, OUT_AV = OUT_AK + (size_t)NPROMPT * 512, OUT_BK = OUT_AV + (size_t)NPROMPT * 512, OUT_BV = OUT_BK + (size_t)NPROMPT * 128;

struct P {
    const float* in[24];
    float* out;
    unsigned char* ws;
};
enum { I_XP = 0, I_XS, I_CAK, I_CAV, I_CBK, I_CBV, I_C, I_CCTX, I_WMOD, I_BMOD, I_GMIXPRE, I_GMIXPOST, I_GFFNPRE, I_GFFNPOST, I_WIN, I_RPB, I_SINK, I_GGA, I_GGB, I_WOUT, I_WUP, I_CONVW, I_CONVB, I_WDOWN };

constexpr int LDS_MAIN = 131072;
constexpr int LDS_BYTES = LDS_MAIN + 256;
constexpr int LDP = 80;

DI unsigned pk_bf16(float lo, float hi) { f32x2 v = {lo, hi}; bf2_t r = __builtin_convertvector(v, bf2_t); return __builtin_bit_cast(unsigned, r); }
DI float wave_sum(float v) {
#pragma unroll
    for (int o = 1; o < 64; o <<= 1) v += __shfl_xor(v, o);
    return v;
}
DI float silu_f(float x) { return x * __builtin_amdgcn_rcpf(1.f + __builtin_amdgcn_exp2f(x * -1.4426950408889634f)); }
DI const float* xrow_ptr(const P& p, int row) { return row < NPROMPT ? p.in[I_XP] + (size_t)row * DM : p.in[I_XS] + (size_t)(row - NPROMPT) * DM; }
DI int cond_of(int row) { return row < NPROMPT ? 0 : 1 + ((row - NPROMPT) >> 10); }
DI float dot4(f32x4 a) { return (a.x * a.x + a.y * a.y) + (a.z * a.z + a.w * a.w); }
DI float hsum4(f32x4 a) { return (a.x + a.y) + (a.z + a.w); }
#define XB_TMO      128
#define XB_XCNT(j)  (256  + 64 * (j))
#define XB_XSUB(j)  (1280 + 64 * (j))
#define XB_XGEN(j)  (2304 + 64 * (j))
#define XB_TOP      3328
#define XB_TOPGEN   3392
#define XCD_BAR_WORDS 3456
#define XB_SPIN_CAP (1u << 18)

__device__ __forceinline__ unsigned xb_ld(unsigned* p)              { return __hip_atomic_load(p, __ATOMIC_RELAXED, __HIP_MEMORY_SCOPE_AGENT); }
__device__ __forceinline__ unsigned xb_add(unsigned* p, unsigned v) { return __hip_atomic_fetch_add(p, v, __ATOMIC_RELAXED, __HIP_MEMORY_SCOPE_AGENT); }
__device__ __forceinline__ unsigned xb_xcc_id() { return (unsigned)__builtin_amdgcn_s_getreg((3 << 11) | 20) & 0xFu; }
#define XB_SPIN(cond, bar) do { unsigned _sp = 0; while (cond) { __builtin_amdgcn_s_sleep(1); \
    if ((++_sp & 255u) == 0u) { if (xb_ld(&(bar)[XB_TMO])) break; if (_sp > XB_SPIN_CAP) { atomicAdd(&(bar)[XB_TMO], 1u); break; } } } } while (0)

struct XcdBarrier {
    unsigned* bar; unsigned x;
    volatile LAS unsigned* st;
};

__device__ __forceinline__ XcdBarrier xcd_barrier_post(unsigned* bar, volatile LAS unsigned* st) {
    XcdBarrier b; b.bar = bar; b.x = xb_xcc_id(); b.st = st;
    if (threadIdx.x == 0) (void)xb_add(&bar[XB_XCNT(b.x)], 1u);
    return b;
}
__device__ __forceinline__ void xcd_barrier_complete(unsigned* bar, unsigned x, unsigned& nloc, unsigned& nx) {
    const unsigned G = gridDim.x * gridDim.y * gridDim.z;
    unsigned sum, cnt, mine, sp = 0u;
    for (;;) {
        sum = 0u; cnt = 0u; mine = 0u;
#pragma unroll
        for (unsigned j = 0; j < 16; ++j) { const unsigned c = xb_ld(&bar[XB_XCNT(j)]); sum += c; cnt += (c > 0u) ? 1u : 0u; mine = (j == x) ? c : mine; }
        if (sum == G) break;
        __builtin_amdgcn_s_sleep(1);
        if ((++sp & 255u) == 0u) { if (xb_ld(&bar[XB_TMO])) break; if (sp > XB_SPIN_CAP) { atomicAdd(&bar[XB_TMO], 1u); break; } }
    }
    nloc = mine > 0u ? mine : 1u; nx = cnt > 0u ? cnt : 1u;
}

__device__ __forceinline__ void xcd_barrier(const XcdBarrier& b) {
    asm volatile("s_waitcnt vmcnt(0)" ::: "memory");
    __syncthreads();
    if (threadIdx.x == 0) {
        unsigned* bar = b.bar;
        __builtin_amdgcn_s_waitcnt(0);
        unsigned nloc = b.st[0], nx = b.st[1];
        if (nloc == 0u) { xcd_barrier_complete(bar, b.x, nloc, nx); b.st[0] = nloc; b.st[1] = nx; }
        const unsigned old = xb_add(&bar[XB_XSUB(b.x)], 1u);
        const unsigned gen = old / nloc;
        if (old + 1u == (gen + 1u) * nloc) {
            __builtin_amdgcn_fence(__ATOMIC_RELEASE, "agent");
            asm volatile("s_waitcnt vmcnt(0)" ::: "memory");
            const unsigned og = xb_add(&bar[XB_TOP], 1u);
            const unsigned tg = og / nx;
            if (og + 1u == (tg + 1u) * nx) xb_add(&bar[XB_TOPGEN], 1u);
            else XB_SPIN(xb_ld(&bar[XB_TOPGEN]) == tg, bar);
            __builtin_amdgcn_fence(__ATOMIC_ACQUIRE, "agent");
            xb_add(&bar[XB_XGEN(b.x)], 1u);
            asm volatile("s_waitcnt vmcnt(0)" ::: "memory");
        } else {
            XB_SPIN(xb_ld(&bar[XB_XGEN(b.x)]) == gen, bar);
            __builtin_amdgcn_fence(__ATOMIC_ACQUIRE, "agent");
            asm volatile("s_waitcnt vmcnt(0)" ::: "memory");
        }
    }
    __syncthreads();
}

DI void p0_adaln(const P& p, int item, float* scr, int tid) {
    const int lane = tid & 63, w = tid >> 6;
    const int c4 = (tid & 7) * 4, rg = tid >> 3;
    const int col = item * 32 + c4;
    const float* wm = p.in[I_WMOD]; const float* cctx = p.in[I_CCTX]; const float* c = p.in[I_C];
    f32x4 wv[16];
#pragma unroll
    for (int i = 0; i < 16; ++i) wv[i] = __builtin_nontemporal_load((const f32x4*)(wm + (size_t)(rg + 64 * i) * 6144 + col));
    f32x4 a0 = {0, 0, 0, 0}, a1 = {0, 0, 0, 0}, a2 = {0, 0, 0, 0};
#pragma unroll
    for (int i = 0; i < 16; ++i) {
        const int row = rg + 64 * i;
        const float s0 = silu_f(cctx[row]), s1 = silu_f(c[row]), s2 = silu_f(c[1024 + row]);
        a0 += wv[i] * s0; a1 += wv[i] * s1; a2 += wv[i] * s2;
    }
#pragma unroll
    for (int o = 8; o < 64; o <<= 1) {
#pragma unroll
        for (int e = 0; e < 4; ++e) { a0[e] += __shfl_xor(a0[e], o); a1[e] += __shfl_xor(a1[e], o); a2[e] += __shfl_xor(a2[e], o); }
    }
    if (lane < 8) { *(f32x4*)(scr + (w * 3 + 0) * 32 + c4) = a0; *(f32x4*)(scr + (w * 3 + 1) * 32 + c4) = a1; *(f32x4*)(scr + (w * 3 + 2) * 32 + c4) = a2; }
    __syncthreads();
    if (tid < 96) {
        const int cond = tid >> 5, cc = tid & 31; float s = 0.f;
#pragma unroll
        for (int ww = 0; ww < 8; ++ww) s += scr[(ww * 3 + cond) * 32 + cc];
        __hip_atomic_store((float*)(p.ws + OFF_MOD) + cond * 6144 + item * 32 + cc, s + p.in[I_BMOD][item * 32 + cc], __ATOMIC_RELAXED, __HIP_MEMORY_SCOPE_AGENT);
    }
    __syncthreads();
}
DI void p0_transpose(const float* W, int N, int srcA, int srcB, int k0, bf16_t* WT, int outrow0, int outK, int outk0, const float* ks, float* scr, int tid) {
    const int c4 = (tid & 63) * 4, r0 = tid >> 6;
    const int scol = c4 < 128 ? srcA + c4 : srcB + (c4 - 128);
    f32x4 v[8];
#pragma unroll
    for (int i = 0; i < 8; ++i) v[i] = *(const f32x4*)(W + (size_t)(k0 + r0 + 8 * i) * N + scol);
#pragma unroll
    for (int i = 0; i < 8; ++i) { if (ks) v[i] *= ks[k0 + r0 + 8 * i]; *(f32x4*)(scr + (r0 + 8 * i) * 260 + c4) = v[i]; }
    __syncthreads();
    const int n = tid >> 1, kh = (tid & 1) * 32;
    const float* s = scr + kh * 260 + n;
#pragma unroll
    for (int q = 0; q < 4; ++q) {
        u32x4 o;
        o.x = pk_bf16(s[(8 * q + 0) * 260], s[(8 * q + 1) * 260]); o.y = pk_bf16(s[(8 * q + 2) * 260], s[(8 * q + 3) * 260]);
        o.z = pk_bf16(s[(8 * q + 4) * 260], s[(8 * q + 5) * 260]); o.w = pk_bf16(s[(8 * q + 6) * 260], s[(8 * q + 7) * 260]);
        *(u32x4*)(WT + (size_t)(outrow0 + n) * outK + outk0 + kh + 8 * q) = o;
    }
    __syncthreads();
}
DI void publish_inc(unsigned* cnt, int tid) {
    asm volatile("s_waitcnt vmcnt(0)" ::: "memory");
    __syncthreads();
    if (tid == 0) { __builtin_amdgcn_fence(__ATOMIC_RELEASE, "agent"); asm volatile("s_waitcnt vmcnt(0)" ::: "memory"); (void)xb_add(cnt, 1u); }
}
DI void publish_inc_wt(unsigned* cnt, int tid) {
    asm volatile("s_waitcnt vmcnt(0)" ::: "memory");
    __syncthreads();
    if (tid == 0) (void)xb_add(cnt, 1u);
}
DI void wait_count(unsigned* cnt, unsigned want, int tid) {
    if (tid == 0) {
        unsigned sp = 0; while (xb_ld(cnt) < want) { __builtin_amdgcn_s_sleep(2); if (++sp > (1u << 22)) break; }
        __builtin_amdgcn_fence(__ATOMIC_ACQUIRE, "agent"); asm volatile("s_waitcnt vmcnt(0)" ::: "memory");
    }
    __syncthreads();
}
constexpr int T_IN = 144, T_OUT = 64, T_UP = 352, T_DOWN = 176;
DI void tr_win(const P& p, int r, float* scr, int tid) { const int kb = r / 9, nbk = r % 9; p0_transpose(p.in[I_WIN], INW, nbk * 256, nbk * 256 + 128, kb * 64, (bf16_t*)(p.ws + OFF_WIN), nbk * 256, 1024, kb * 64, nullptr, scr, tid); }
DI void tr_wout(const P& p, int r, float* scr, int tid) { const int kb = r >> 2, nbk = r & 3, half = kb >> 3;
    p0_transpose(p.in[I_WOUT], 1024, nbk * 256, nbk * 256 + 128, kb * 64, (bf16_t*)(p.ws + OFF_WOUT), half * 1024 + nbk * 256, 512, (kb & 7) * 64, half ? p.in[I_GGB] - 512 : p.in[I_GGA], scr, tid); }
DI void tr_wup(const P& p, int r, float* scr, int tid) { const int kb = r / 22, tl = r % 22; p0_transpose(p.in[I_WUP], UPW, tl * 128, DFF + tl * 128, kb * 64, (bf16_t*)(p.ws + OFF_WUP), tl * 256, 1024, kb * 64, nullptr, scr, tid); }
DI void tr_wdown(const P& p, int r, float* scr, int tid) { const int kb = r >> 2, nbk = r & 3, sp = kb / 22;
    p0_transpose(p.in[I_WDOWN], 1024, nbk * 256, nbk * 256 + 128, kb * 64, (bf16_t*)(p.ws + OFF_WDOWN), sp * 1024 + nbk * 256, 1408, (kb - 22 * sp) * 64, nullptr, scr, tid); }
struct TrDesc { const float* W; const float* ks; bf16_t* WT; int N, srcA, srcB, k0, outrow0, outK, outk0; };
DI TrDesc tr_desc(const P& p, int r) {
    TrDesc d; d.ks = nullptr;
    if (r < T_IN) { const int kb = r / 9, nbk = r % 9; d.W = p.in[I_WIN]; d.N = INW; d.srcA = nbk * 256; d.srcB = nbk * 256 + 128; d.k0 = kb * 64; d.WT = (bf16_t*)(p.ws + OFF_WIN); d.outrow0 = nbk * 256; d.outK = 1024; d.outk0 = kb * 64; return d; }
    r -= T_IN;
    if (r < T_OUT) { const int kb = r >> 2, nbk = r & 3, half = kb >> 3; d.W = p.in[I_WOUT]; d.N = 1024; d.srcA = nbk * 256; d.srcB = nbk * 256 + 128; d.k0 = kb * 64; d.WT = (bf16_t*)(p.ws + OFF_WOUT); d.outrow0 = half * 1024 + nbk * 256; d.outK = 512; d.outk0 = (kb & 7) * 64;
        d.ks = half ? p.in[I_GGB] - 512 : p.in[I_GGA]; return d; }
    r -= T_OUT;
    if (r < T_UP) { const int kb = r / 22, tl = r % 22; d.W = p.in[I_WUP]; d.N = UPW; d.srcA = tl * 128; d.srcB = DFF + tl * 128; d.k0 = kb * 64; d.WT = (bf16_t*)(p.ws + OFF_WUP); d.outrow0 = tl * 256; d.outK = 1024; d.outk0 = kb * 64; return d; }
    r -= T_UP;
    { const int kb = r >> 2, nbk = r & 3, sp = kb / 22; d.W = p.in[I_WDOWN]; d.N = 1024; d.srcA = nbk * 256; d.srcB = nbk * 256 + 128; d.k0 = kb * 64; d.WT = (bf16_t*)(p.ws + OFF_WDOWN); d.outrow0 = sp * 1024 + nbk * 256; d.outK = 1408; d.outk0 = (kb - 22 * sp) * 64; return d; }
}
DI void tr_load(const TrDesc& d, f32x4 (&v)[8], int tid) {
    const int c4 = (tid & 63) * 4, r0 = tid >> 6; const int scol = c4 < 128 ? d.srcA + c4 : d.srcB + (c4 - 128);
#pragma unroll
    for (int i = 0; i < 8; ++i) { v[i] = __builtin_nontemporal_load((const f32x4*)(d.W + (size_t)(d.k0 + r0 + 8 * i) * d.N + scol)); }
}
DI void tr_range(const P& p, int first, int end, int stride, float* scr, int tid) {
    if (first >= end) return;
    f32x4 v[8];
    TrDesc d = tr_desc(p, first);
    tr_load(d, v, tid);
    for (int it = first; it < end; it += stride) {
        const int c4 = (tid & 63) * 4, r0 = tid >> 6;
#pragma unroll
        for (int i = 0; i < 8; ++i) { f32x4 t = v[i]; if (d.ks) t *= d.ks[d.k0 + r0 + 8 * i]; *(f32x4*)(scr + (r0 + 8 * i) * 260 + c4) = t; }
        const TrDesc cur = d;
        if (it + stride < end) { d = tr_desc(p, it + stride); tr_load(d, v, tid); }
        __syncthreads();
        const int n = tid >> 1, kh = (tid & 1) * 32;
        const float* sp = scr + kh * 260 + n;
#pragma unroll
        for (int q = 0; q < 4; ++q) {
            u32x4 o;
            o.x = pk_bf16(sp[(8 * q + 0) * 260], sp[(8 * q + 1) * 260]); o.y = pk_bf16(sp[(8 * q + 2) * 260], sp[(8 * q + 3) * 260]);
            o.z = pk_bf16(sp[(8 * q + 4) * 260], sp[(8 * q + 5) * 260]); o.w = pk_bf16(sp[(8 * q + 6) * 260], sp[(8 * q + 7) * 260]);
            *(u32x4*)(cur.WT + (size_t)(cur.outrow0 + n) * cur.outK + cur.outk0 + kh + 8 * q) = o;
        }
        __syncthreads();
    }
}
DI void p0_phase(const P& p, int bid, int nb, float* scr, int tid, unsigned* cntA) {
    constexpr int T_AD = 192, N_CV = 80;
    constexpr int NITEMS = T_AD + N_CV;
    for (int it = bid; it < NITEMS; it += nb) {
        int r = it;
        if (r < T_AD) { p0_adaln(p, r, scr, tid); if (r < 64) publish_inc_wt(cntA, tid); continue; }
        r -= T_AD;
        {
            const size_t e0 = (size_t)r * 8192;
#pragma unroll
            for (int i = 0; i < 2; ++i) {
                const size_t e = e0 + (size_t)(i * NTHR + tid) * 8;
                const float* src; bf16_t* dst;
                if (e < 262144) { src = p.in[I_CAK] + e; dst = (bf16_t*)(p.ws + OFF_CAK) + e; }
                else if (e < 524288) { src = p.in[I_CAV] + (e - 262144); dst = (bf16_t*)(p.ws + OFF_CAV) + (e - 262144); }
                else if (e < 589824) { src = p.in[I_CBK] + (e - 524288); dst = (bf16_t*)(p.ws + OFF_CBK) + (e - 524288); }
                else { src = p.in[I_CBV] + (e - 589824); dst = (bf16_t*)(p.ws + OFF_CBV) + (e - 589824); }
                const f32x4 a = *(const f32x4*)src, b = *(const f32x4*)(src + 4);
                u32x4 o; o.x = pk_bf16(a.x, a.y); o.y = pk_bf16(a.z, a.w); o.z = pk_bf16(b.x, b.y); o.w = pk_bf16(b.z, b.w);
                *(u32x4*)dst = o;
            }
        }
    }
    __syncthreads();
    if (nb == 256) { if (bid >= 192) tr_range(p, bid - 192, T_IN, 64, scr, tid); }
    else tr_range(p, bid, T_IN, nb, scr, tid);
}

DI f32x4 ld_bf4(const bf16_t* p) { const u32x2 r = *(const u32x2*)p; f32x4 o; o.x = __uint_as_float(r.x << 16); o.y = __uint_as_float(r.x & 0xffff0000u); o.z = __uint_as_float(r.y << 16); o.w = __uint_as_float(r.y & 0xffff0000u); return o; }
template <int RP> DI void p1_rows(const P& p, const int gw, const int ngw, const int rend, const int lane, unsigned* waitcnt = nullptr, int tid = 0) {
    bf16_t* H = (bf16_t*)(p.ws + OFF_H);
    for (int row0 = gw; row0 < rend; row0 += RP * ngw) {
        f32x4 v[RP][4];
#pragma unroll
        for (int k = 0; k < RP; ++k) { const int row = row0 + k * ngw; if (row < rend) { const float* x = xrow_ptr(p, row);
#pragma unroll
            for (int j = 0; j < 4; ++j) v[k][j] = __builtin_nontemporal_load((const f32x4*)(x + 4 * lane + 256 * j)); } }
        if (waitcnt) { wait_count(waitcnt, 64u, tid); waitcnt = nullptr; }
#pragma unroll
        for (int k = 0; k < RP; ++k) { const int row = row0 + k * ngw; if (row < rend) {
            const float* mod = (const float*)(p.ws + OFF_MOD) + cond_of(row) * 6144;
            f32x4 g[4], sh[4], sc[4];
#pragma unroll
            for (int j = 0; j < 4; ++j) { const int col = 4 * lane + 256 * j; g[j] = *(const f32x4*)(p.in[I_GMIXPRE] + col); sh[j] = *(const f32x4*)(mod + col); sc[j] = *(const f32x4*)(mod + 1024 + col); }
            float s = 0.f;
#pragma unroll
            for (int j = 0; j < 4; ++j) s += dot4(v[k][j]);
            const float rstd = rsqrtf(wave_sum(s) * (1.f / DM) + EPS);
#pragma unroll
            for (int j = 0; j < 4; ++j) {
                const int col = 4 * lane + 256 * j;
                const f32x4 h = (v[k][j] * rstd) * g[j] * (sc[j] + 1.f) + sh[j];
                u32x2 o; o.x = pk_bf16(h.x, h.y); o.y = pk_bf16(h.z, h.w);
                *(u32x2*)(H + (size_t)row * DM + col) = o;
            } } }
    }
}
template <int RP> DI void p5_rows(const P& p, const int gw, const int ngw, const int rend, const int lane, unsigned* waitcnt = nullptr, int tid = 0) {
    bf16_t* H = (bf16_t*)(p.ws + OFF_H); const bf16_t* MA = (const bf16_t*)(p.ws + OFF_MIX); const bf16_t* MB = MA + (size_t)NTOK * DM; const float* SS = (const float*)(p.ws + OFF_SS);
    for (int row0 = gw; row0 < rend; row0 += RP * ngw) {
        f32x4 xv[RP][4]; u32x2 ma[RP][4], mb[RP][4]; float sv[RP];
#pragma unroll
        for (int k = 0; k < RP; ++k) { const int row = row0 + k * ngw; if (row < rend) { const float* x = xrow_ptr(p, row);
            sv[k] = (lane < 16) ? SS[(size_t)row * 16 + lane] : 0.f;
#pragma unroll
            for (int j = 0; j < 4; ++j) { const int col = 4 * lane + 256 * j; xv[k][j] = __builtin_nontemporal_load((const f32x4*)(x + col)); } } }
        if (waitcnt) { wait_count(waitcnt, 8u, tid); waitcnt = nullptr; }
#pragma unroll
        for (int k = 0; k < RP; ++k) { const int row = row0 + k * ngw; if (row < rend) {
#pragma unroll
            for (int j = 0; j < 4; ++j) { const int col = 4 * lane + 256 * j; ma[k][j] = __builtin_nontemporal_load((const u32x2*)(MA + (size_t)row * DM + col)); mb[k][j] = __builtin_nontemporal_load((const u32x2*)(MB + (size_t)row * DM + col)); } } }
#pragma unroll
        for (int k = 0; k < RP; ++k) { const int row = row0 + k * ngw; if (row < rend) {
            const float* mod = (const float*)(p.ws + OFF_MOD) + cond_of(row) * 6144;
            float sa = (lane < 8) ? sv[k] : 0.f, sb = (lane >= 8) ? sv[k] : 0.f;
            sa = wave_sum(sa); sb = wave_sum(sb);
            const float rsa = rsqrtf(sa * (1.f / 512.f) + EPS), rsb = rsqrtf(sb * (1.f / 512.f) + EPS);
            f32x4 mx[4]; float sm = 0.f;
#pragma unroll
            for (int j = 0; j < 4; ++j) {
                f32x4 a, b; a.x = __uint_as_float(ma[k][j].x << 16); a.y = __uint_as_float(ma[k][j].x & 0xffff0000u); a.z = __uint_as_float(ma[k][j].y << 16); a.w = __uint_as_float(ma[k][j].y & 0xffff0000u);
                b.x = __uint_as_float(mb[k][j].x << 16); b.y = __uint_as_float(mb[k][j].x & 0xffff0000u); b.z = __uint_as_float(mb[k][j].y << 16); b.w = __uint_as_float(mb[k][j].y & 0xffff0000u);
                mx[j] = a * rsa + b * rsb; sm += dot4(mx[j]); }
            const float rstd_m = rsqrtf(wave_sum(sm) * (1.f / DM) + EPS);
            float s = 0.f;
#pragma unroll
            for (int j = 0; j < 4; ++j) {
                const int col = 4 * lane + 256 * j;
                const f32x4 g = *(const f32x4*)(p.in[I_GMIXPOST] + col), gt = *(const f32x4*)(mod + 2048 + col);
                xv[k][j] = xv[k][j] + gt * ((mx[j] * rstd_m) * g);
                { u32x2 ox; ox.x = pk_bf16(xv[k][j].x, xv[k][j].y); ox.y = pk_bf16(xv[k][j].z, xv[k][j].w); *(u32x2*)((bf16_t*)(p.ws + OFF_Z) + (size_t)row * DM + col) = ox; }
                s += dot4(xv[k][j]);
            }
            const float rstd = rsqrtf(wave_sum(s) * (1.f / DM) + EPS);
#pragma unroll
            for (int j = 0; j < 4; ++j) {
                const int col = 4 * lane + 256 * j;
                const f32x4 g = *(const f32x4*)(p.in[I_GFFNPRE] + col), sh = *(const f32x4*)(mod + 3072 + col), sc = *(const f32x4*)(mod + 4096 + col);
                const f32x4 h = (xv[k][j] * rstd) * g * (sc + 1.f) + sh;
                u32x2 o; o.x = pk_bf16(h.x, h.y); o.y = pk_bf16(h.z, h.w);
                *(u32x2*)(H + (size_t)row * DM + col) = o;
            } } }
    }
}
template <int RP> DI void p8_rows(const P& p, const int gw, const int ngw, const int rend, const int lane, unsigned* waitcnt = nullptr, int tid = 0) {
    const bf16_t* F0 = (const bf16_t*)(p.ws + OFF_MIX); const bf16_t* F1 = F0 + (size_t)NTOK * DM;
    for (int row0 = gw; row0 < rend; row0 += RP * ngw) {
        f32x4 x1[RP][4]; u32x2 fa[RP][4], fb[RP][4];
#pragma unroll
        for (int k = 0; k < RP; ++k) { const int row = row0 + k * ngw; if (row < rend) {
#pragma unroll
            for (int j = 0; j < 4; ++j) { const int col = 4 * lane + 256 * j; x1[k][j] = ld_bf4((const bf16_t*)(p.ws + OFF_Z) + (size_t)row * DM + col); } } }
        if (waitcnt) { wait_count(waitcnt, 8u, tid); waitcnt = nullptr; }
#pragma unroll
        for (int k = 0; k < RP; ++k) { const int row = row0 + k * ngw; if (row < rend) {
#pragma unroll
            for (int j = 0; j < 4; ++j) { const int col = 4 * lane + 256 * j; fa[k][j] = __builtin_nontemporal_load((const u32x2*)(F0 + (size_t)row * DM + col)); fb[k][j] = __builtin_nontemporal_load((const u32x2*)(F1 + (size_t)row * DM + col)); } } }
#pragma unroll
        for (int k = 0; k < RP; ++k) { const int row = row0 + k * ngw; if (row < rend) {
            const float* mod = (const float*)(p.ws + OFF_MOD) + cond_of(row) * 6144;
            f32x4 fv[4]; float s = 0.f;
#pragma unroll
            for (int j = 0; j < 4; ++j) {
                f32x4 a, b; a.x = __uint_as_float(fa[k][j].x << 16); a.y = __uint_as_float(fa[k][j].x & 0xffff0000u); a.z = __uint_as_float(fa[k][j].y << 16); a.w = __uint_as_float(fa[k][j].y & 0xffff0000u);
                b.x = __uint_as_float(fb[k][j].x << 16); b.y = __uint_as_float(fb[k][j].x & 0xffff0000u); b.z = __uint_as_float(fb[k][j].y << 16); b.w = __uint_as_float(fb[k][j].y & 0xffff0000u);
                fv[j] = a + b; s += dot4(fv[j]); }
            const float rstd_f = rsqrtf(wave_sum(s) * (1.f / DM) + EPS);
#pragma unroll
            for (int j = 0; j < 4; ++j) {
                const int col = 4 * lane + 256 * j;
                const f32x4 g = *(const f32x4*)(p.in[I_GFFNPOST] + col), gt = *(const f32x4*)(mod + 5120 + col);
                __builtin_nontemporal_store(x1[k][j] + gt * ((fv[j] * rstd_f) * g), (f32x4*)(p.out + OUT_Y + (size_t)row * DM + col));
            } } }
    }
}

struct EpiInproj {
    static constexpr bool PERM = false, AFTER_DRAIN = false;
    bf16_t* Z; float* out;
    DI void operator()(const f32x4 (&acc)[2][2][4][2], const pg8::Unit& u, int wr, int wc, int fr, int fq) const {
        const bool sample = (u.pm >= 16);
        const int pn = u.pn;
        const bool isq = (pn < 2) || (pn == 6) || (pn == 7);
        float inv[4];
#pragma unroll
        for (int e = 0; e < 4; ++e) inv[e] = __builtin_amdgcn_exp2f(-(float)(fq * 4 + e) * (13.287712379549449f / 16.f)) * 0.15915494309189535f;
#pragma unroll
        for (int bj = 0; bj < 2; ++bj) {
            const bool rope = sample && (pn == 6 || pn == 7 || (pn == 8 && bj == 0));
            float* fo = nullptr; int fpitch = 0, fcol = 0;
            if (!sample) {
                if (pn == 2 || pn == 3) { fo = out + OUT_AK; fpitch = 512; fcol = (pn - 2) * 256 + bj * 128; }
                else if (pn == 4 || pn == 5) { fo = out + OUT_AV; fpitch = 512; fcol = (pn - 4) * 256 + bj * 128; }
                else if (pn == 8) { fo = out + (bj == 0 ? OUT_BK : OUT_BV); fpitch = 128; fcol = 0; }
            }
            const int zcol = pn * 256 + bj * 128 + wc * 32 + 4 * fq;
            const float qs = isq ? 0.18033688011112042f : 1.f;
#pragma unroll
            for (int ai = 0; ai < 2; ++ai)
#pragma unroll
                for (int m = 0; m < 4; ++m) {
                    const int grow = u.pm * 256 + ai * 128 + wr * 64 + m * 16 + fr;
                    f32x4 v0 = acc[ai][bj][m][0], v1 = acc[ai][bj][m][1];
                    if (fo) { float* fp = fo + (size_t)grow * fpitch + fcol + wc * 32 + 4 * fq; __builtin_nontemporal_store(v0, (f32x4*)fp); __builtin_nontemporal_store(v1, (f32x4*)(fp + 16)); }
                    if (rope) {
                        const int pos = (grow - NPROMPT) & 1023; const float ps = (wc & 1) ? (float)(pos & 63) : (float)(pos >> 6);
#pragma unroll
                        for (int e = 0; e < 4; ++e) {
                            float a = ps * inv[e]; a -= floorf(a);
                            const float cs = __builtin_amdgcn_cosf(a), sn = __builtin_amdgcn_sinf(a);
                            const float x1 = v0[e], x2 = v1[e];
                            v0[e] = x1 * cs - x2 * sn; v1[e] = x2 * cs + x1 * sn;
                        }
                    }
                    v0 *= qs; v1 *= qs;
                    bf16_t* zp = Z + (size_t)grow * INW + zcol;
                    u32x2 o0, o1; o0.x = pk_bf16(v0.x, v0.y); o0.y = pk_bf16(v0.z, v0.w); o1.x = pk_bf16(v1.x, v1.y); o1.y = pk_bf16(v1.z, v1.w);
                    { auto rx = __builtin_amdgcn_permlane16_swap(o0.x, o1.x, false, false); auto ry = __builtin_amdgcn_permlane16_swap(o0.y, o1.y, false, false);
                      u32x4 o4; o4.x = rx[0]; o4.y = ry[0]; o4.z = rx[1]; o4.w = ry[1];
                      *(u32x4*)(zp + ((fq & 1) ? 12 : 0)) = o4; }
                }
        }
    }
};
DI void st16_wt(void* ptr, u32x4 v) { asm volatile("global_store_dwordx4 %0, %1, off sc1\n\ts_nop 1" :: "v"(ptr), "v"(v) : "memory"); }
struct EpiF32 {
    static constexpr bool PERM = true, AFTER_DRAIN = false;
    bf16_t* O;
    DI void operator()(const f32x4 (&acc)[2][2][4][2], const pg8::Unit& u, int wr, int wc, int fr, int fq) const {
        bf16_t* base = O + (size_t)(u.pn >> 2) * NTOK * DM + (u.pn & 3) * 256 + wc * 32 + 8 * fq;
#pragma unroll
        for (int ai = 0; ai < 2; ++ai)
#pragma unroll
            for (int m = 0; m < 4; ++m) {
                bf16_t* rp = base + (size_t)(u.pm * 256 + ai * 128 + wr * 64 + m * 16 + fr) * DM;
#pragma unroll
                for (int bj = 0; bj < 2; ++bj) {
                    const f32x4 v0 = acc[ai][bj][m][0], v1 = acc[ai][bj][m][1];
                    u32x4 o; o.x = pk_bf16(v0.x, v0.y); o.y = pk_bf16(v0.z, v0.w); o.z = pk_bf16(v1.x, v1.y); o.w = pk_bf16(v1.z, v1.w);
                    st16_wt(rp + bj * 128, o);
                }
            }
    }
};
DI float dpp_prev(float x) { int u_; asm("" : "=v"(u_)); return __builtin_bit_cast(float, __builtin_amdgcn_update_dpp(u_, __builtin_bit_cast(int, x), 0x121, 0xf, 0xf, true)); }
DI float dpp_next(float x) { int u_; asm("" : "=v"(u_)); return __builtin_bit_cast(float, __builtin_amdgcn_update_dpp(u_, __builtin_bit_cast(int, x), 0x12f, 0xf, 0xf, true)); }
template <bool WT> struct EpiUp {
    static constexpr bool PERM = WT, AFTER_DRAIN = false;
    bf16_t* ACT; const float* cw; const float* cb;
    DI void operator()(const f32x4 (&acc)[2][2][4][2], const pg8::Unit& u, int wr, int wc, int fr, int fq) const {
#pragma unroll
        for (int ai = 0; ai < 2; ++ai) {
            const int tok0 = 62 * (u.pm * 4 + ai * 2 + wr) - 1;
            u32x2 keep[4];
#pragma unroll
            for (int n = 0; n < 2; ++n) {
                const int j = WT ? u.pn * 128 + wc * 32 + 8 * fq + 4 * n : u.pn * 128 + wc * 32 + 16 * n + 4 * fq;
                const f32x4 wg0 = *(const f32x4*)(cw + j), wg1 = *(const f32x4*)(cw + UPW + j), wg2 = *(const f32x4*)(cw + 2 * UPW + j), bg = *(const f32x4*)(cb + j);
                const f32x4 wv0 = *(const f32x4*)(cw + DFF + j), wv1 = *(const f32x4*)(cw + UPW + DFF + j), wv2 = *(const f32x4*)(cw + 2 * UPW + DFF + j), bv = *(const f32x4*)(cb + DFF + j);
#pragma unroll
                for (int m = 0; m < 4; ++m) {
                    const int local = m * 16 + fr, token = tok0 + local;
                    const f32x4 gc = acc[ai][0][m][n], vc = acc[ai][1][m][n];
                    const f32x4 gpa = acc[ai][0][m > 0 ? m - 1 : 0][n], vpa = acc[ai][1][m > 0 ? m - 1 : 0][n];
                    const f32x4 gna = acc[ai][0][m < 3 ? m + 1 : 3][n], vna = acc[ai][1][m < 3 ? m + 1 : 3][n];
                    f32x4 gp, gn, vp, vn;
#pragma unroll
                    for (int e = 0; e < 4; ++e) {
                        gp[e] = dpp_prev(fr == 15 ? gpa[e] : gc[e]); gn[e] = dpp_next(fr == 0 ? gna[e] : gc[e]);
                        vp[e] = dpp_prev(fr == 15 ? vpa[e] : vc[e]); vn[e] = dpp_next(fr == 0 ? vna[e] : vc[e]);
                    }
                    const int pos = token < NPROMPT ? (token & 255) : ((token - NPROMPT) & 1023), L = token < NPROMPT ? 256 : 1024;
                    const float mp = pos > 0 ? 1.f : 0.f, mn = pos < L - 1 ? 1.f : 0.f;
                    f32x4 g, v;
                    if (__builtin_amdgcn_ballot_w64(mp == 0.f || mn == 0.f) == 0ull) {
                        g = gp * wg0 + gc * wg1 + gn * wg2 + bg; v = vp * wv0 + vc * wv1 + vn * wv2 + bv;
                    } else {
                        g = (gp * mp) * wg0 + gc * wg1 + (gn * mn) * wg2 + bg; v = (vp * mp) * wv0 + vc * wv1 + (vn * mn) * wv2 + bv;
                    }
                    f32x4 a;
#pragma unroll
                    for (int e = 0; e < 4; ++e) a[e] = silu_f(g[e]) * v[e];
                    u32x2 o; o.x = pk_bf16(a.x, a.y); o.y = pk_bf16(a.z, a.w);
                    if (WT) {
                        if (n == 0) keep[m] = o;
                        else if (local >= 1 && local <= 62 && token < NTOK) { u32x4 o4; o4.x = keep[m].x; o4.y = keep[m].y; o4.z = o.x; o4.w = o.y; st16_wt(ACT + (size_t)token * DFF + (j - 4), o4); }
                    } else {
                        if ((m & 1) == 0) keep[m] = o;
                        else {
                            auto rx = __builtin_amdgcn_permlane16_swap(keep[m - 1].x, o.x, false, false); auto ry = __builtin_amdgcn_permlane16_swap(keep[m - 1].y, o.y, false, false);
                            u32x4 o4; o4.x = rx[0]; o4.y = ry[0]; o4.z = rx[1]; o4.w = ry[1];
                            const bool oddq = (fq & 1) != 0; const int loc = oddq ? local : local - 16, tok = tok0 + loc;
                            if (loc >= 1 && loc <= 62 && tok < NTOK) *(u32x4*)(ACT + (size_t)tok * DFF + (oddq ? j - 4 : j)) = o4;
                        }
                    }
                }
            }
        }
    }
};

DI void tr_read8(unsigned a0, unsigned a1, unsigned a2, unsigned a3, unsigned a4, unsigned a5, unsigned a6, unsigned a7,
                 s16x4& r0, s16x4& r1, s16x4& r2, s16x4& r3, s16x4& r4, s16x4& r5, s16x4& r6, s16x4& r7) {
    asm volatile("ds_read_b64_tr_b16 %0, %8\n\tds_read_b64_tr_b16 %1, %9\n\tds_read_b64_tr_b16 %2, %10\n\tds_read_b64_tr_b16 %3, %11\n\t"
                 "ds_read_b64_tr_b16 %4, %12\n\tds_read_b64_tr_b16 %5, %13\n\tds_read_b64_tr_b16 %6, %14\n\tds_read_b64_tr_b16 %7, %15\n\ts_waitcnt lgkmcnt(0)"
                 : "=&v"(r0), "=&v"(r1), "=&v"(r2), "=&v"(r3), "=&v"(r4), "=&v"(r5), "=&v"(r6), "=&v"(r7)
                 : "v"(a0), "v"(a1), "v"(a2), "v"(a3), "v"(a4), "v"(a5), "v"(a6), "v"(a7) : "memory");
}
typedef short v4i16_t __attribute__((ext_vector_type(4)));
DI s16x4 vtr(LAS const unsigned char* p) { return __builtin_bit_cast(s16x4, __builtin_amdgcn_ds_read_tr16_b64_v4i16((LAS v4i16_t*)p)); }
DI float quad_max(float v) {
    auto a = __builtin_amdgcn_permlane16_swap(__float_as_uint(v), __float_as_uint(v), false, false);
    const float t = fmaxf(__uint_as_float(a[0]), __uint_as_float(a[1]));
    auto b = __builtin_amdgcn_permlane32_swap(__float_as_uint(t), __float_as_uint(t), false, false);
    return fmaxf(__uint_as_float(b[0]), __uint_as_float(b[1]));
}
DI float quad_sum(float v) {
    auto a = __builtin_amdgcn_permlane16_swap(__float_as_uint(v), __float_as_uint(v), false, false);
    const float t = __uint_as_float(a[0]) + __uint_as_float(a[1]);
    auto b = __builtin_amdgcn_permlane32_swap(__float_as_uint(t), __float_as_uint(t), false, false);
    return __uint_as_float(b[0]) + __uint_as_float(b[1]);
}
struct AttState { f32x4 o[4]; float m, l; };
struct AttUnit { int tq0, qcol, ktok0, kcol, vcol, nt0, nt1, ocol, slot, kstart, rs0, qb, cpitch; const bf16_t* ck; const bf16_t* cv; float m0, l0; };
template <int MODE>
DI void att_tile(AttState& st, const bf16_t* Kt, const LAS unsigned char* Vt3, const bf16x8 (&qf)[2], const int lr, const int quad, const int dq, const int ws, const float* bt, const int (&bidx)[2][4]) {
    constexpr int NKT = (MODE == 2) ? 2 : 4;
    const int koff = (MODE == 2) ? ws : 0;
    f32x4 s[NKT];
    bf16x8 kf[NKT][2];
#pragma unroll
    for (int kt = 0; kt < NKT; ++kt)
#pragma unroll
        for (int ks = 0; ks < 2; ++ks) kf[kt][ks] = *(const bf16x8*)(Kt + (koff + kt * 16 + lr) * LDP + ks * 32 + quad * 8);
    __builtin_amdgcn_s_setprio(1);
#pragma unroll
    for (int kt = 0; kt < NKT; ++kt) {
        s[kt] = __builtin_amdgcn_mfma_f32_16x16x32_bf16(kf[kt][0], qf[0], (f32x4){0.f, 0.f, 0.f, 0.f}, 0, 0, 0);
        s[kt] = __builtin_amdgcn_mfma_f32_16x16x32_bf16(kf[kt][1], qf[1], s[kt], 0, 0, 0);
    }
    __builtin_amdgcn_s_setprio(0);
    const LAS unsigned char* vrow = Vt3 + (unsigned)(((koff + quad * 4 + (lr >> 2)) * LDP + 4 * (lr & 3)) * 2);
    s16x4 vlo[NKT / 2][4], vhi[NKT / 2][4];
#pragma unroll
    for (int s2 = 0; s2 < NKT / 2; ++s2)
#pragma unroll
        for (int d = 0; d < 4; ++d) { vlo[s2][d] = vtr(vrow + s2 * 32 * LDP * 2 + d * 32); vhi[s2][d] = vtr(vrow + (s2 * 32 + 16) * LDP * 2 + d * 32); }
    if (MODE == 1) {
#pragma unroll
        for (int kt = 0; kt < NKT; ++kt)
#pragma unroll
            for (int e = 0; e < 4; ++e) { int dd = dq - (kt * 16 + quad * 4 + e); dd = dd < 0 ? -dd : dd; s[kt][e] = (dd <= 128) ? s[kt][e] : -INFINITY; }
    }
    if (MODE == 2) {
#pragma unroll
        for (int kt = 0; kt < NKT; ++kt)
#pragma unroll
            for (int e = 0; e < 4; ++e) s[kt][e] += bt[bidx[kt][e]];
    }
    float mx = fmaxf(fmaxf(fmaxf(s[0][0], s[0][1]), fmaxf(s[0][2], s[0][3])), fmaxf(fmaxf(s[1][0], s[1][1]), fmaxf(s[1][2], s[1][3])));
    if (NKT == 4) mx = fmaxf(mx, fmaxf(fmaxf(fmaxf(s[NKT - 2][0], s[NKT - 2][1]), fmaxf(s[NKT - 2][2], s[NKT - 2][3])), fmaxf(fmaxf(s[NKT - 1][0], s[NKT - 1][1]), fmaxf(s[NKT - 1][2], s[NKT - 1][3]))));
    mx = quad_max(mx);
    const float m_new = fmaxf(st.m, mx);
    if (__builtin_amdgcn_ballot_w64(m_new > st.m) != 0ull) {
        const float alpha = __builtin_amdgcn_exp2f(st.m - m_new);
        st.l *= alpha;
        const f32x2 a2 = {alpha, alpha};
#pragma unroll
        for (int d = 0; d < 4; ++d) { f32x2 lo = {st.o[d][0], st.o[d][1]}, hi = {st.o[d][2], st.o[d][3]}; lo *= a2; hi *= a2; st.o[d] = (f32x4){lo.x, lo.y, hi.x, hi.y}; }
        st.m = m_new;
    }
    const f32x2 mm = {m_new, m_new};
    f32x2 ps2 = {0.f, 0.f};
#pragma unroll
    for (int kt = 0; kt < NKT; ++kt) {
        f32x2 lo = {s[kt][0], s[kt][1]}, hi = {s[kt][2], s[kt][3]}; lo -= mm; hi -= mm;
        s[kt][0] = __builtin_amdgcn_exp2f(lo.x); s[kt][1] = __builtin_amdgcn_exp2f(lo.y); s[kt][2] = __builtin_amdgcn_exp2f(hi.x); s[kt][3] = __builtin_amdgcn_exp2f(hi.y);
        ps2 += (f32x2){s[kt][0], s[kt][1]}; ps2 += (f32x2){s[kt][2], s[kt][3]};
    }
    st.l += ps2.x + ps2.y;
#pragma unroll
    for (int s2 = 0; s2 < NKT / 2; ++s2) {
        u32x4 pbu; pbu.x = pk_bf16(s[2 * s2][0], s[2 * s2][1]); pbu.y = pk_bf16(s[2 * s2][2], s[2 * s2][3]); pbu.z = pk_bf16(s[2 * s2 + 1][0], s[2 * s2 + 1][1]); pbu.w = pk_bf16(s[2 * s2 + 1][2], s[2 * s2 + 1][3]);
        const bf16x8 pb = __builtin_bit_cast(bf16x8, pbu);
        __builtin_amdgcn_s_setprio(1);
#pragma unroll
        for (int d = 0; d < 4; ++d) st.o[d] = __builtin_amdgcn_mfma_f32_16x16x32_bf16(__builtin_shufflevector(vlo[s2][d], vhi[s2][d], 0, 1, 2, 3, 4, 5, 6, 7), pb, st.o[d], 0, 0, 0);
        __builtin_amdgcn_s_setprio(0);
    }
}
template <int TYPE>
DI void attn_unit(const P& p, const AttUnit& au, unsigned char* lds, const int tid, const bool reuse_kv = false) {
    bf16_t* Kl = (bf16_t*)lds; bf16_t* Vl = Kl + 256 * LDP; float* rpbl = (float*)(lds + 2 * 256 * LDP * 2);
    const LAS unsigned char* Vl3 = (const LAS unsigned char*)lds + 256 * LDP * 2;
    const int w = tid >> 6, lane = tid & 63, lr = lane & 15, quad = lane >> 4;
    const bf16_t* Z = (const bf16_t*)(p.ws + OFF_Z);
    const int total = au.nt0 + au.nt1, nchunks = (total + 3) >> 2;
    const int qidx = w * 16 + lr;
    if (!reuse_kv) __syncthreads();
    int bidx[2][4] = {{0, 0, 0, 0}, {0, 0, 0, 0}}; int ws = 0, rsg = 0;
    if (TYPE == 2) {
        const int hh = au.ocol >> 6;
        if (tid < 480) { const int dr = tid >> 5, c = tid & 31; rpbl[tid] = c < 31 ? p.in[I_RPB][hh * 465 + dr * 31 + c] * 1.4426950408889634f : -INFINITY; }
        const int wq = w & 3; ws = wq == 0 ? 0 : (wq == 1 ? 8 : (wq == 2 ? 24 : 32));
        const int qc = qidx & 63; int cs = qc - 8; cs = cs < 0 ? 0 : (cs > 48 ? 48 : cs);
#pragma unroll
        for (int kt = 0; kt < 2; ++kt)
#pragma unroll
            for (int e = 0; e < 4; ++e) { const int kc = ws + kt * 16 + quad * 4 + e; int dc = kc - qc; dc = dc < -15 ? -15 : (dc > 15 ? 15 : dc); bidx[kt][e] = ((kc >= cs) && (kc < cs + 16)) ? dc + 15 : 31; }
        rsg = 2 * au.qb + (w >> 2) - 4; rsg = rsg < 0 ? 0 : (rsg > 8 ? 8 : rsg);
    }
    bf16x8 qf[2];
    {
        const bf16_t* qp = Z + (size_t)(au.tq0 + qidx) * INW + au.qcol + quad * 8;
        qf[0] = __builtin_nontemporal_load((const bf16x8*)qp); qf[1] = __builtin_nontemporal_load((const bf16x8*)(qp + 32));
    }
    AttState st;
#pragma unroll
    for (int d = 0; d < 4; ++d) st.o[d] = (f32x4){0.f, 0.f, 0.f, 0.f};
    st.m = au.m0; st.l = (quad == 0) ? au.l0 : 0.f;
    u32x4 rk[4], rv[4];
#define ATT_PREFETCH(c) do { _Pragma("unroll") for (int i_ = 0; i_ < 4; ++i_) { const int pc_ = tid + NTHR * i_, row_ = pc_ >> 3, c16_ = (pc_ & 7) * 8; const int ti_ = 4 * (c) + (row_ >> 6); \
        if (ti_ < total) { const bf16_t *kp_, *vp_; \
            if (ti_ < au.nt0) { const size_t ro_ = (size_t)(au.ktok0 + ti_ * 64 + (row_ & 63)) * INW + c16_; kp_ = Z + ro_ + au.kcol; vp_ = Z + ro_ + au.vcol; } \
            else { const size_t ro_ = (size_t)((ti_ - au.nt0) * 64 + (row_ & 63)) * au.cpitch + c16_; kp_ = au.ck + ro_; vp_ = au.cv + ro_; } \
            rk[i_] = *(const u32x4*)kp_; rv[i_] = *(const u32x4*)vp_; } } } while (0)
    if (!reuse_kv) ATT_PREFETCH(0);
    for (int c = 0; c < nchunks; ++c) {
        if (!(reuse_kv && c == 0)) {
        if (c > 0) __syncthreads();
#pragma unroll
        for (int i = 0; i < 4; ++i) { const int pc = tid + NTHR * i, lo_ = (pc >> 3) * LDP + (pc & 7) * 8; *(u32x4*)(Kl + lo_) = rk[i]; *(u32x4*)(Vl + lo_) = rv[i]; }
        __syncthreads();
        }
        if (c + 1 < nchunks) ATT_PREFETCH(c + 1);
        for (int tt = 0; tt < 4; ++tt) {
            const int t = 4 * c + tt;
            if (t >= total) break;
            const bf16_t* Kt = Kl + tt * 64 * LDP; const LAS unsigned char* Vt3 = Vl3 + tt * 64 * LDP * 2;
            if (TYPE == 2 && t < au.nt0) {
                const int kr = au.rs0 + t; if (kr < rsg || kr >= rsg + 8) continue;
                const int drow = kr - (2 * au.qb + (w >> 2)) + 7;
                att_tile<2>(st, Kt, Vt3, qf, lr, quad, 0, ws, rpbl + drow * 32, bidx);
            } else if (TYPE == 3 && t < au.nt0) {
                const int qw = au.qb * 128 + w * 16, k0 = au.kstart + t * 64;
                if (k0 + 63 < qw - 128 || k0 > qw + 15 + 128) continue;
                if (k0 < qw + 15 - 128 || k0 + 63 > qw + 128) att_tile<1>(st, Kt, Vt3, qf, lr, quad, au.qb * 128 + qidx - k0, 0, nullptr, bidx);
                else att_tile<0>(st, Kt, Vt3, qf, lr, quad, 0, 0, nullptr, bidx);
            } else att_tile<0>(st, Kt, Vt3, qf, lr, quad, 0, 0, nullptr, bidx);
        }
    }
#undef ATT_PREFETCH
    bf16_t* O = (bf16_t*)(p.ws + OFF_O); float* SS = (float*)(p.ws + OFF_SS);
    const float il = 1.f / quad_sum(st.l);
    const int tok = au.tq0 + qidx;
    float ss = 0.f;
#pragma unroll
    for (int d = 0; d < 4; ++d) {
        const f32x4 v = st.o[d] * il; ss += dot4(v);
        u32x2 ov; ov.x = pk_bf16(v.x, v.y); ov.y = pk_bf16(v.z, v.w);
        *(u32x2*)(O + (size_t)tok * DM + au.ocol + d * 16 + quad * 4) = ov;
    }
    ss = quad_sum(ss);
    if (quad == 0) SS[(size_t)tok * 16 + au.slot] = ss;
}
DI void attn_phase(const P& p, int bid, int nb, unsigned char* lds, int tid) {
    for (int u = bid; u < 768; u += nb) {
        int type, b, h, qb;
        if (u < 128) { type = 2; b = u >> 6; h = (u >> 3) & 7; qb = u & 7; }
        else if (u < 256) { type = 3; const int v = u - 128; b = v >> 6; h = (v >> 3) & 7; qb = v & 7; }
        else { const int pr = (u - 256) & 255; qb = (u - 256) >> 8; type = pr >> 7; b = (pr >> 3) & 15; h = pr & 7; }
        const bool reuse = (nb == 256) && (u >= 512);
        AttUnit au; au.qb = qb; au.nt1 = 0; au.kstart = 0; au.rs0 = 0; au.ck = nullptr; au.cv = nullptr; au.cpitch = 0; au.m0 = -1e30f; au.l0 = 0.f;
        if (type == 0) { au.tq0 = b * 256 + qb * 128; au.qcol = h * 64; au.ktok0 = b * 256; au.kcol = 512 + h * 64; au.vcol = 1024 + h * 64; au.nt0 = 4; au.ocol = h * 64; au.slot = h; attn_unit<0>(p, au, lds, tid, reuse); }
        else if (type == 1) { au.tq0 = b * 256 + qb * 128; au.qcol = 1536 + h * 64; au.ktok0 = b * 256; au.kcol = 2048 + (h >> 2) * 64; au.vcol = 2176 + (h >> 2) * 64; au.nt0 = 4; au.ocol = 512 + h * 64; au.slot = 8 + h;
            au.m0 = p.in[I_SINK][h] * 1.4426950408889634f; au.l0 = 1.f; attn_unit<1>(p, au, lds, tid, reuse); }
        else if (type == 2) { au.tq0 = NPROMPT + b * 1024 + qb * 128; au.qcol = h * 64;
            int rs0 = 2 * qb - 4; rs0 = rs0 < 0 ? 0 : (rs0 > 8 ? 8 : rs0); int rs1 = 2 * qb + 1 - 4; rs1 = rs1 < 0 ? 0 : (rs1 > 8 ? 8 : rs1); au.rs0 = rs0;
            au.ktok0 = NPROMPT + b * 1024 + rs0 * 64; au.kcol = 512 + h * 64; au.vcol = 1024 + h * 64; au.nt0 = rs1 + 8 - rs0; au.ocol = h * 64; au.slot = h;
            au.nt1 = 4; au.ck = (const bf16_t*)(p.ws + OFF_CAK) + (size_t)b * 256 * 512 + h * 64; au.cv = (const bf16_t*)(p.ws + OFF_CAV) + (size_t)b * 256 * 512 + h * 64; au.cpitch = 512; attn_unit<2>(p, au, lds, tid); }
        else { au.tq0 = NPROMPT + b * 1024 + qb * 128; au.qcol = 1536 + h * 64; int kstart = qb * 128 - 128; if (kstart < 0) kstart = 0; int kend = qb * 128 + 256; if (kend > 1024) kend = 1024; au.kstart = kstart;
            au.ktok0 = NPROMPT + b * 1024 + kstart; au.kcol = 2048 + (h >> 2) * 64; au.vcol = 2176 + (h >> 2) * 64; au.nt0 = (kend - kstart) >> 6; au.ocol = 512 + h * 64; au.slot = 8 + h;
            au.nt1 = 4; au.ck = (const bf16_t*)(p.ws + OFF_CBK) + (size_t)b * 256 * 128 + (h >> 2) * 64; au.cv = (const bf16_t*)(p.ws + OFF_CBV) + (size_t)b * 256 * 128 + (h >> 2) * 64; au.cpitch = 128;
            au.m0 = p.in[I_SINK][h] * 1.4426950408889634f; au.l0 = 1.f; attn_unit<3>(p, au, lds, tid); }
    }
}

struct UpOrder {
    int c, tail;
    DI bool next(int i, pg8::Unit& u) const {
        if (tail) { if (i > 0 || c >= 38) return false; u.pm = c >> 1; u.pn = (c & 1) ? 21 : 10; return true; }
        if (i >= 2) return false;
        const int s = i * 256 + (c & 7) * 32 + (c >> 3);
        if (s < 500) { const int g = s / 160, w = s % 160, gsz = (g < 3) ? 8 : 1; u.pm = 8 * g + (w % gsz); const int pi = w / gsz; u.pn = pi < 10 ? pi : pi + 1; }
        else { const int e = s - 500; u.pm = 19 + (e >> 1); u.pn = (e & 1) ? 21 : 10; }
        return true;
    }
    DI void a_ready(const pg8::Unit&) const {}
    DI void done(const pg8::Unit&) const {}
};
constexpr int CNT_BASE = 4096;
__global__ void __launch_bounds__(NTHR, 2) mega(P p) {
    extern __shared__ __attribute__((aligned(16))) unsigned char lds[];
    const int tid = threadIdx.x, bid = blockIdx.x, nb = gridDim.x, lane = tid & 63, wv = tid >> 6;
    volatile LAS unsigned* bst = (volatile LAS unsigned*)((LAS unsigned char*)lds + LDS_MAIN);
    if (tid < 16) bst[tid] = 0u;
    __syncthreads();
    unsigned* ctl = (unsigned*)(p.ws + OFF_BAR);
    XcdBarrier bar = xcd_barrier_post(ctl, bst);
    unsigned* cntA = ctl + CNT_BASE;
    unsigned* cnt4 = ctl + CNT_BASE + 64;
    unsigned* cnt7 = ctl + CNT_BASE + 64 + 24 * 64;
    LAS unsigned char* lds3 = (LAS unsigned char*)lds;
    float* scr = (float*)lds;
    bf16_t* wsH = (bf16_t*)(p.ws + OFF_H);
    const bool std_grid = (nb == 256);
    p0_phase(p, bid, nb, scr, tid, cntA);
    p1_rows<3>(p, bid * NWAVE + wv, nb * NWAVE, NTOK, lane, cntA, tid);
    xcd_barrier(bar);
    {
        pg8::Gemm g{wsH, (const bf16_t*)(p.ws + OFF_WIN), 1024, 1024, 1 << 30, 0, 0, nullptr, 0}; pg8::StaticOrder S; S.init(NTOK, INW, nb, bid);
        EpiInproj E{(bf16_t*)(p.ws + OFF_Z), p.out};
        pg8::gemm_phase<EpiInproj, pg8::StaticOrder, true, true>(lds3, g, S, E);
        __syncthreads();
        const int h0 = std_grid ? 216 : 0, nh = nb - h0;
        if (bid >= h0) tr_range(p, T_IN + (bid - h0), T_IN + T_OUT + 200, nh, scr, tid);
    }
    xcd_barrier(bar);
    attn_phase(p, bid, nb, lds, tid);
    xcd_barrier(bar);
    {
        pg8::Gemm g{(const bf16_t*)(p.ws + OFF_O), (const bf16_t*)(p.ws + OFF_WOUT), 512, 1024, 4, 1024, 0, nullptr, 0}; pg8::StaticOrder S; S.init(NTOK, 2048, nb, bid);
        EpiF32 E{(bf16_t*)(p.ws + OFF_MIX)};
        pg8::gemm_phase<EpiF32, pg8::StaticOrder, true, true>(lds3, g, S, E);
        __syncthreads();
        const int h0 = std_grid ? 192 : 0, nh = nb - h0;
        if (bid >= h0) tr_range(p, T_IN + T_OUT + 200 + (bid - h0), T_IN + T_OUT + T_UP + T_DOWN, nh, scr, tid);
        pg8::Unit u;
        if (nb >= 192) {
            if (S.next(0, u)) { publish_inc_wt(cnt4 + 64 * u.pm, tid); const int r0 = u.pm * 256 + u.pn * 32; p5_rows<4>(p, r0 + wv, NWAVE, r0 + 32, lane, cnt4 + 64 * u.pm, tid); }
        } else { xcd_barrier(bar); p5_rows<3>(p, bid * NWAVE + wv, nb * NWAVE, NTOK, lane); }
    }
    xcd_barrier(bar);
    unsigned* tflag = ctl + CNT_BASE + 64 + 48 * 64;
    {
        pg8::Gemm g{wsH, (const bf16_t*)(p.ws + OFF_WUP), 1024, 1024, 1 << 30, 0, 1, nullptr, 0}; UpOrder S{bid, 0};
        EpiUp<false> E{(bf16_t*)(p.ws + OFF_ACT), p.in[I_CONVW], p.in[I_CONVB]};
        pg8::gemm_phase<EpiUp<false>, UpOrder, true, true>(lds3, g, S, E);
    }
    xcd_barrier(bar);
    if (bid < 38) {
        pg8::Gemm g{wsH, (const bf16_t*)(p.ws + OFF_WUP), 1024, 1024, 1 << 30, 0, 1, nullptr, 0}; UpOrder S{bid, 1};
        EpiUp<true> E{(bf16_t*)(p.ws + OFF_ACT), p.in[I_CONVW], p.in[I_CONVB]};
        pg8::gemm_phase<EpiUp<true>, UpOrder, true, true>(lds3, g, S, E);
        publish_inc_wt(tflag + ((bid >> 1) * 2 + (bid & 1)) * 64, tid);
    } else {
        pg8::Gemm g{(const bf16_t*)(p.ws + OFF_ACT), (const bf16_t*)(p.ws + OFF_WDOWN), 1408, 2816, 4, 2816, 0, tflag, 18}; pg8::StaticOrder S; S.init(NTOK, 2048, nb, bid - 38);
        EpiF32 E{(bf16_t*)(p.ws + OFF_MIX)};
        pg8::gemm_phase<EpiF32, pg8::StaticOrder, true, true>(lds3, g, S, E);
        pg8::Unit u;
        if (S.next(0, u)) { publish_inc_wt(cnt7 + 64 * u.pm, tid); const int r0 = u.pm * 256 + u.pn * 32; p8_rows<4>(p, r0 + wv, NWAVE, r0 + 32, lane, cnt7 + 64 * u.pm, tid); }
    }
}

extern "C" void kernel_launch(void* const* d_in, const int* in_sizes, int n_in, void* d_out, int out_size, void* d_ws, size_t ws_size, hipStream_t stream) {
    static int grid_blocks = 0;
    if (!grid_blocks) {
        int dev = 0, cus = 0, per_cu = 0;
        (void)hipGetDevice(&dev);
        (void)hipDeviceGetAttribute(&cus, hipDeviceAttributeMultiprocessorCount, dev);
        (void)hipFuncSetAttribute((const void*)mega, hipFuncAttributeMaxDynamicSharedMemorySize, LDS_BYTES);
        (void)hipOccupancyMaxActiveBlocksPerMultiprocessor(&per_cu, (const void*)mega, NTHR, LDS_BYTES);
        if (per_cu < 1) { fprintf(stderr, "kernel_launch: occupancy query reports %d blocks per CU\n", per_cu); per_cu = 1; }
        grid_blocks = cus;
        if (cus != 256) fprintf(stderr, "kernel_launch: this kernel's unit orders are built for 256 CUs (MI355X); found %d\n", cus);
        if (n_in != 24 || ws_size < WS_END) fprintf(stderr, "kernel_launch: unexpected n_in %d / ws_size %zu (need %zu)\n", n_in, ws_size, (size_t)WS_END);
    }
    P p{};
    for (int i = 0; i < 24; ++i) p.in[i] = (const float*)d_in[i];
    p.out = (float*)d_out; p.ws = (unsigned char*)d_ws;
    (void)hipMemsetAsync((unsigned char*)d_ws + OFF_BAR, 0, 65536, stream);
    void* args[] = {&p};
    hipError_t e = hipLaunchCooperativeKernel((const void*)mega, dim3(grid_blocks), dim3(NTHR), args, LDS_BYTES, stream);
    if (e != hipSuccess) fprintf(stderr, "cooperative launch failed: %s (grid %d)\n", hipGetErrorString(e), grid_blocks);
}
```
